# Optimizing an MI355X kernel written in HIP

```python
import math
import jax, jax.numpy as jnp
from jax import lax
import numpy as np

D_MODEL = 1024
BATCH = 4
SEQ = 8192
DEPTH = 1

D_MIX = D_MODEL
D_RWKV = D_MIX // 2
D_S5 = D_MIX - D_RWKV
RWKV_HEAD = 64
N_RWKV_HEADS = D_RWKV // RWKV_HEAD
LORA_W = 64
LORA_A = 64
LORA_G = 128
S5_CH = 16
N_S5_GROUPS = D_S5 // S5_CH
S5_STATE = 64
D_FF = ((8 * D_MODEL // 3 + 255) // 256) * 256
D_SHIFT = 3 * D_RWKV + LORA_W + LORA_A + LORA_G
D_IN = D_SHIFT + D_S5
NORM_EPS = 1e-6
LNX_EPS = 64e-5
DT_MIN = 1e-3
DT_MAX = 1e-1

kernel_name = "hybrid_rwkv7_s5_adaln_block"


def rms_norm(x, eps=NORM_EPS):
    xf = x.astype(jnp.float32)
    y = xf * lax.rsqrt(jnp.mean(xf * xf, axis=-1, keepdims=True) + eps)
    return y.astype(x.dtype)


def modulate(h, shift, scale):
    return h * (1.0 + scale[:, None, :]) + shift[:, None, :]


def rwkv7_time_mix(z, w0, w2, a0, a2, g2, k_k, k_a, r_k, lnx_w, lnx_b):
    out_dtype = z.dtype
    z = z.astype(jnp.float32)
    bsz, seq = z.shape[0], z.shape[1]
    H, N = N_RWKV_HEADS, RWKV_HEAD
    o = 0
    r = z[..., o:o + D_RWKV]; o += D_RWKV
    k = z[..., o:o + D_RWKV]; o += D_RWKV
    v = z[..., o:o + D_RWKV]; o += D_RWKV
    w_lo = z[..., o:o + LORA_W]; o += LORA_W
    a_lo = z[..., o:o + LORA_A]; o += LORA_A
    g_lo = z[..., o:o + LORA_G]

    w = -jax.nn.softplus(-(w0 + jnp.tanh(w_lo) @ w2)) - 0.5
    decay = jnp.exp(-jnp.exp(w))
    a = jax.nn.sigmoid(a0 + a_lo @ a2)
    g = jax.nn.sigmoid(g_lo) @ g2
    kk = (k * k_k).reshape(bsz, seq, H, N)
    kk = kk / jnp.maximum(jnp.linalg.norm(kk, axis=-1, keepdims=True), 1e-12)
    k = k * (1.0 + (a - 1.0) * k_a)

    heads = lambda t: t.reshape(bsz, seq, H, N)
    r_h, k_h, v_h, w_h, a_h = heads(r), heads(k), heads(v), heads(decay), heads(a)
    tm = lambda t: jnp.transpose(t, (1, 0, 2, 3))
    xs = (tm(r_h), tm(w_h), tm(k_h), tm(v_h), tm(-kk), tm(kk * a_h))

    def step(S, inp):
        r_t, w_t, k_t, v_t, a_t, b_t = inp
        sa = jnp.einsum("bhvk,bhk->bhv", S, a_t)
        S = S * w_t[:, :, None, :] + sa[..., None] * b_t[:, :, None, :] + v_t[..., None] * k_t[:, :, None, :]
        y = jnp.einsum("bhvk,bhk->bhv", S, r_t)
        return S, y

    S0 = jnp.zeros((bsz, H, N, N), jnp.float32)
    _, y = lax.scan(step, S0, xs)
    y = jnp.transpose(y, (1, 0, 2, 3))

    mu = jnp.mean(y, axis=-1, keepdims=True)
    var = jnp.mean(jnp.square(y - mu), axis=-1, keepdims=True)
    y = (y - mu) * lax.rsqrt(var + LNX_EPS) * lnx_w.reshape(H, N) + lnx_b.reshape(H, N)
    y = y + jnp.sum(r_h * k_h * r_k, axis=-1, keepdims=True) * v_h
    return (y.reshape(bsz, seq, D_RWKV) * g).astype(out_dtype)


def _ssm_combine(e1, e2):
    ar1, ai1, br1, bi1 = e1
    ar2, ai2, br2, bi2 = e2
    ar = ar2 * ar1 - ai2 * ai1
    ai = ar2 * ai1 + ai2 * ar1
    br = ar2 * br1 - ai2 * bi1 + br2
    bi = ar2 * bi1 + ai2 * br1 + bi2
    return ar, ai, br, bi


def s5_mix(u, a_re, a_im, log_dt, b_re, b_im, c_re, c_im, d_skip, w_glu, b_glu, gain):
    out_dtype = u.dtype
    u = u.astype(jnp.float32)
    bsz, seq = u.shape[0], u.shape[1]
    G, P = N_S5_GROUPS, S5_STATE
    ug = u.reshape(bsz, seq, G, S5_CH)

    dt = jnp.exp(log_dt)[:, None]
    mag = jnp.exp(dt * a_re)
    abar_re = mag * jnp.cos(dt * a_im)
    abar_im = mag * jnp.sin(dt * a_im)
    den = a_re * a_re + a_im * a_im
    p, q = abar_re - 1.0, abar_im
    coef_re = (p * a_re + q * a_im) / den
    coef_im = (q * a_re - p * a_im) / den
    bbar_re = coef_re[..., None] * b_re - coef_im[..., None] * b_im
    bbar_im = coef_re[..., None] * b_im + coef_im[..., None] * b_re

    bu_re = jnp.einsum("gpc,btgc->tbgp", bbar_re, ug)
    bu_im = jnp.einsum("gpc,btgc->tbgp", bbar_im, ug)
    a_seq_re = jnp.broadcast_to(abar_re[None, None], (seq, 1, G, P))
    a_seq_im = jnp.broadcast_to(abar_im[None, None], (seq, 1, G, P))
    _, _, s_re, s_im = lax.associative_scan(_ssm_combine, (a_seq_re, a_seq_im, bu_re, bu_im), axis=0)

    y = (jnp.einsum("gcp,tbgp->btgc", c_re, s_re) - jnp.einsum("gcp,tbgp->btgc", c_im, s_im)
         + d_skip * ug).reshape(bsz, seq, D_S5)
    zz = jax.nn.gelu(y)
    out = zz * jax.nn.sigmoid(zz @ w_glu + b_glu)
    return (rms_norm(out) * gain).astype(out_dtype)


def setup_inputs(seed: int = 0) -> dict:
    key = jax.random.key(seed)
    ks = jax.random.split(key, 40)
    L = DEPTH
    nrm = lambda k, shape, s: jax.random.normal(k, shape, jnp.float32) * s
    uni = lambda k, shape, lo, hi: jax.random.uniform(k, shape, jnp.float32, lo, hi)
    H, N, G, P = N_RWKV_HEADS, RWKV_HEAD, N_S5_GROUPS, S5_STATE
    return {
        "x": nrm(ks[0], (BATCH, SEQ, D_MODEL), 1.0),
        "c": nrm(ks[1], (BATCH, D_MODEL), 1.0),
        "w_ada": nrm(ks[2], (L, D_MODEL, 6 * D_MODEL), D_MODEL ** -0.5),
        "b_ada": nrm(ks[3], (L, 6 * D_MODEL), 0.01),
        "w_in": nrm(ks[4], (L, D_MODEL, D_IN), D_MODEL ** -0.5),
        "mu_shift": uni(ks[5], (L, D_SHIFT), 0.0, 1.0),
        "rw_w0": uni(ks[6], (L, D_RWKV), -6.0, 1.0),
        "rw_w2": nrm(ks[7], (L, LORA_W, D_RWKV), 0.5 * LORA_W ** -0.5),
        "rw_a0": nrm(ks[8], (L, D_RWKV), 0.1),
        "rw_a2": nrm(ks[9], (L, LORA_A, D_RWKV), 0.5 * LORA_A ** -0.5),
        "rw_g2": nrm(ks[10], (L, LORA_G, D_RWKV), LORA_G ** -0.5),
        "rw_k_k": 0.85 + nrm(ks[11], (L, D_RWKV), 0.05),
        "rw_k_a": 1.0 + nrm(ks[12], (L, D_RWKV), 0.05),
        "rw_r_k": nrm(ks[13], (L, H, N), 0.1),
        "rw_lnx_w": 1.0 + nrm(ks[14], (L, D_RWKV), 0.05),
        "rw_lnx_b": nrm(ks[15], (L, D_RWKV), 0.01),
        "s5_a_re": -0.5 + nrm(ks[16], (L, G, P), 0.01),
        "s5_a_im": math.pi * jnp.arange(P, dtype=jnp.float32)[None, None, :] + nrm(ks[17], (L, G, P), 0.01),
        "s5_log_dt": uni(ks[18], (L, G), math.log(DT_MIN), math.log(DT_MAX)),
        "s5_b_re": nrm(ks[19], (L, G, P, S5_CH), (2 * S5_CH) ** -0.5),
        "s5_b_im": nrm(ks[20], (L, G, P, S5_CH), (2 * S5_CH) ** -0.5),
        "s5_c_re": nrm(ks[21], (L, G, S5_CH, P), (2 * P) ** -0.5),
        "s5_c_im": nrm(ks[22], (L, G, S5_CH, P), (2 * P) ** -0.5),
        "s5_d": nrm(ks[23], (L, G, S5_CH), 1.0),
        "s5_w_glu": nrm(ks[24], (L, D_S5, D_S5), D_S5 ** -0.5),
        "s5_b_glu": nrm(ks[25], (L, D_S5), 0.01),
        "s5_gain": 1.0 + nrm(ks[26], (L, D_S5), 0.05),
        "w_out": nrm(ks[27], (L, D_MIX, D_MODEL), D_MIX ** -0.5),
        "ffn_w_gate": nrm(ks[28], (L, D_MODEL, D_FF), D_MODEL ** -0.5),
        "ffn_w_up": nrm(ks[29], (L, D_MODEL, D_FF), D_MODEL ** -0.5),
        "ffn_w_down": nrm(ks[30], (L, D_FF, D_MODEL), D_FF ** -0.5),
        "final_gain": 1.0 + nrm(ks[31], (D_MODEL,), 0.05),
    }


def reference(x, c, w_ada, b_ada, w_in, mu_shift, rw_w0, rw_w2, rw_a0, rw_a2, rw_g2,
              rw_k_k, rw_k_a, rw_r_k, rw_lnx_w, rw_lnx_b, s5_a_re, s5_a_im, s5_log_dt,
              s5_b_re, s5_b_im, s5_c_re, s5_c_im, s5_d, s5_w_glu, s5_b_glu, s5_gain,
              w_out, ffn_w_gate, ffn_w_up, ffn_w_down, final_gain):
    c_act = jax.nn.silu(c)
    for l in range(DEPTH):
        ada = c_act @ w_ada[l] + b_ada[l]
        sh_m, sc_m, g_m, sh_f, sc_f, g_f = jnp.split(ada, 6, axis=-1)

        h = modulate(rms_norm(x), sh_m, sc_m)
        proj = h @ w_in[l]
        z = proj[..., :D_SHIFT]
        u = proj[..., D_SHIFT:]
        z_prev = jnp.pad(z[:, :-1], ((0, 0), (1, 0), (0, 0)))
        z = z + mu_shift[l] * (z_prev - z)
        y_rwkv = rwkv7_time_mix(z, rw_w0[l], rw_w2[l], rw_a0[l], rw_a2[l], rw_g2[l],
                                rw_k_k[l], rw_k_a[l], rw_r_k[l], rw_lnx_w[l], rw_lnx_b[l])
        y_s5 = s5_mix(u, s5_a_re[l], s5_a_im[l], s5_log_dt[l], s5_b_re[l], s5_b_im[l],
                      s5_c_re[l], s5_c_im[l], s5_d[l], s5_w_glu[l], s5_b_glu[l], s5_gain[l])
        mix = jnp.concatenate([y_rwkv, y_s5], axis=-1) @ w_out[l]
        x = x + g_m[:, None, :] * mix

        h = modulate(rms_norm(x), sh_f, sc_f)
        ffn = (jax.nn.silu(h @ ffn_w_gate[l]) * (h @ ffn_w_up[l])) @ ffn_w_down[l]
        x = x + g_f[:, None, :] * ffn
    return rms_norm(x) * final_gain
```

```cpp
#include <hip/hip_runtime.h>
#include <hip/hip_cooperative_groups.h>
#include <cstdio>
#include <cstdint>
namespace cg = cooperative_groups;

#define LAS __attribute__((address_space(3)))
typedef unsigned short bf16_t;
typedef short bf16x8 __attribute__((ext_vector_type(8)));
typedef float f32x4 __attribute__((ext_vector_type(4)));
typedef float f32x2 __attribute__((ext_vector_type(2)));
typedef unsigned u32x4 __attribute__((ext_vector_type(4)));
typedef unsigned u32x2 __attribute__((ext_vector_type(2)));

constexpr int NT = 32768, SEQ = 8192, NB = 4, DM = 1024, DIN = 2304, DFF = 2816, NH = 8, NG = 32;
constexpr size_t MiB = 1ull << 20;
constexpr size_t WS_WIN_T = 0;
constexpr size_t WS_LORA_T = WS_WIN_T + (size_t)2304 * 1024 * 2;
constexpr size_t WS_WGLU_T = WS_LORA_T + (size_t)1536 * 256 * 2;
constexpr size_t WS_WOUT_T = WS_WGLU_T + (size_t)512 * 512 * 2;
constexpr size_t WS_GU_T = WS_WOUT_T + (size_t)1024 * 1024 * 2;
constexpr size_t WS_DOWN_T = WS_GU_T + (size_t)5632 * 1024 * 2;
constexpr size_t WS_S5W = WS_DOWN_T + (size_t)1024 * 2816 * 2;
constexpr size_t WS_S5TV = WS_S5W + (size_t)32 * 256 * 256 * 2;
constexpr size_t WS_WEND = WS_S5TV + (size_t)32 * 256 * 384 * 2;
static_assert(WS_WEND <= 36 * MiB, "weights region");
constexpr size_t WS_SMALL = 36 * MiB;
constexpr size_t SM_CTR = 0;
constexpr size_t ZERO_BYTES = 4096;
constexpr size_t SM_ADA = ZERO_BYTES;
constexpr size_t SM_BIAS1 = SM_ADA + 4 * 6144 * 4;
constexpr size_t SM_BIAS2 = SM_BIAS1 + 4 * 2304 * 4;
constexpr size_t SM_RSTD1 = SM_BIAS2 + 4 * 5632 * 4;
constexpr size_t SM_RSP5 = SM_RSTD1 + NT * 4;
constexpr size_t SM_RSP2 = SM_RSP5 + (size_t)NT * 8 * 4;
constexpr size_t SM_END = SM_RSP2 + (size_t)NT * 16 * 4;
static_assert(SM_END <= 4 * MiB, "small region");
constexpr size_t WS_A1 = 40 * MiB;
constexpr size_t WS_WR = 40 * MiB;
constexpr size_t WS_KP = 72 * MiB;
constexpr size_t WS_MIX = 200 * MiB;
constexpr size_t WS_R = 104 * MiB;
constexpr size_t WS_K = 136 * MiB;
constexpr size_t WS_V = 168 * MiB;
constexpr size_t WS_YPHI = 104 * MiB;
constexpr size_t WS_SH = 120 * MiB;
constexpr size_t WS_ZZ = 136 * MiB;
constexpr size_t WS_GLUO = 168 * MiB;
constexpr size_t WS_LO = 200 * MiB;
constexpr size_t WS_SLOC = 200 * MiB;
constexpr size_t WS_USIN = 216 * MiB;
constexpr size_t WS_LA = 264 * MiB;
constexpr size_t WS_W = 280 * MiB;
constexpr size_t WS_AA = 344 * MiB;
constexpr size_t WS_Y = 312 * MiB;
constexpr size_t WS_G = 376 * MiB;
constexpr size_t WS_AL = 408 * MiB;
constexpr size_t WS_BE = 440 * MiB;
constexpr size_t WS_VS = 472 * MiB;
constexpr size_t WS_SC = 504 * MiB;
constexpr size_t WS_X1 = 104 * MiB;
constexpr size_t WS_X2B = 168 * MiB;
constexpr size_t WS_A2 = 40 * MiB;
constexpr size_t WS_HMID = 296 * MiB;
constexpr size_t WS_RSP3 = 508 * MiB;
constexpr size_t WS_END = 510 * MiB;
#ifndef DUP
#define DUP 0
#endif
#define REP(bit) for (int rep_ = 0; rep_ < (((DUP) >> (bit)) & 1) + 1; ++rep_)

struct Params {
    const float* in[32];
    float* out;
    unsigned char* ws;
};

__device__ __forceinline__ float bf2f(unsigned short b) { return __uint_as_float(((unsigned)b) << 16); }
__device__ __forceinline__ unsigned short f2bf(float f) { unsigned u = __float_as_uint(f); u += 0x7FFFu + ((u >> 16) & 1u); return (unsigned short)(u >> 16); }
__device__ __forceinline__ unsigned cvt_pk_bf16(float lo, float hi) { unsigned r; asm volatile("v_cvt_pk_bf16_f32 %0, %1, %2" : "=v"(r) : "v"(lo), "v"(hi)); return r; }
__device__ __forceinline__ float bflo(unsigned w) { return __uint_as_float(w << 16); }
__device__ __forceinline__ float bfhi(unsigned w) { return __uint_as_float(w & 0xffff0000u); }
__device__ __forceinline__ float sigmoidf_(float x) { return 1.0f / (1.0f + __expf(-x)); }
__device__ __forceinline__ float siluf_(float x) { return x * sigmoidf_(x); }
__device__ __forceinline__ float tanhf_(float x) { const float e = __expf(2.0f * x); return 1.0f - 2.0f / (e + 1.0f); }
__device__ __forceinline__ float gelu_tanh(float y) { const float u = 0.7978845608028654f * (y + 0.044715f * y * y * y); return 0.5f * y * (1.0f + tanhf_(u)); }
__device__ __forceinline__ float wave_sum(float v) {
#pragma unroll
    for (int o = 32; o >= 1; o >>= 1) v += __shfl_xor(v, o);
    return v;
}
template <int CTRL> __device__ __forceinline__ float dpp_f(float x) { return __builtin_bit_cast(float, __builtin_amdgcn_update_dpp(0, __builtin_bit_cast(int, x), CTRL, 0xF, 0xF, false)); }
__device__ __forceinline__ float red16(float x) { x += dpp_f<0x128>(x); x += dpp_f<0x124>(x); x += dpp_f<0x122>(x); x += dpp_f<0x121>(x); return x; }

__device__ __forceinline__ float red8(float x) { x += dpp_f<0xB1>(x); x += dpp_f<0x4E>(x); x += dpp_f<0x141>(x); return x; }
__device__ __forceinline__ void unpack8(u32x4 v, float (&o)[8]) { o[0] = bflo(v.x); o[1] = bfhi(v.x); o[2] = bflo(v.y); o[3] = bfhi(v.y); o[4] = bflo(v.z); o[5] = bfhi(v.z); o[6] = bflo(v.w); o[7] = bfhi(v.w); }
__device__ __forceinline__ u32x4 pack8a(const float (&v)[8]) { u32x4 w; w.x = cvt_pk_bf16(v[0], v[1]); w.y = cvt_pk_bf16(v[2], v[3]); w.z = cvt_pk_bf16(v[4], v[5]); w.w = cvt_pk_bf16(v[6], v[7]); return w; }
template <class T> __device__ __forceinline__ T ldnt(const T* p) { return __builtin_nontemporal_load(p); }
template <class T> __device__ __forceinline__ void stnt(T* p, T v) { __builtin_nontemporal_store(v, p); }
__device__ __forceinline__ int otid() { int t = threadIdx.x; asm volatile("" : "+v"(t)); return t; }
namespace pg8 {
constexpr int BM = 256, BK = 64, HALF = 128, HTB = HALF * BK * 2, STAGE_BYTES = 8 * HTB, NXCD = 8, WGM = 8;
__host__ __device__ __forceinline__ int lds_byte(int r, int c) { const int st = (r >> 4) * 2 + (c >> 5), rr = r & 15, cc = c & 31, ob = rr * 64 + cc * 2; return st * 1024 + (ob ^ (((ob >> 9) & 1) << 5)); }
__host__ __device__ __forceinline__ void stage_rc(int b, int& R, int& C) { const int st = b / 1024, sb = b % 1024, swz = sb ^ (((sb >> 9) & 1) << 5); R = (st >> 1) * 16 + swz / 64; C = (st & 1) * 32 + (swz % 64) / 2; }
__host__ __device__ __forceinline__ int perm32(int rho) { const int n = rho >> 4, i = rho & 15; return 8 * (i >> 2) + 4 * n + (i & 3); }

struct Unit { int pm, pn; };
struct Gemm { const bf16_t* A; const bf16_t* Bt; int M, N, K, lda, ldb, gm; size_t gstrideB; };

struct StaticOrder {
    int nM, nN, nwg, G, c;
    __host__ __device__ void init(int M, int N, int G_, int c_) { nM = M / BM; nN = N / BM; nwg = nM * nN; G = G_; c = c_; }
    __host__ __device__ bool next(int i, Unit& u) const {
        const long L = (long)i * G + c; if (L >= nwg) return false;
        int wgid = (int)L; { const int q = nwg / NXCD, r = nwg % NXCD, xcd = wgid % NXCD, off = wgid / NXCD; wgid = (xcd < r ? xcd * (q + 1) : r * (q + 1) + (xcd - r) * q) + off; }
        const int nig = WGM * nN, gid = wgid / nig, fm = gid * WGM, gsz = (nM - fm) < WGM ? (nM - fm) : WGM;
        u.pm = fm + ((wgid % nig) % gsz); u.pn = (wgid % nig) / gsz; return true;
    }
};

template <class Epi, class Sched>
__device__ __forceinline__ void gemm_phase(LAS unsigned char* lds, const Gemm g, const Sched& S, const Epi& E) {
    int tid_ = otid(); asm volatile("" : "+v"(tid_));
    const int tid = tid_, wid = __builtin_amdgcn_readfirstlane(tid >> 6), lane = tid & 63, wr = wid >> 2, wc = wid & 3, fr = lane & 15, fq = lane >> 4;
    const int K = g.K, nt = K / BK;
    unsigned voffA, voffB;
    { int R, C; stage_rc(tid * 16, R, C); const int Rb = Epi::PERM ? ((R & ~31) + perm32(R & 31)) : R;
        voffA = (unsigned)(R * g.lda + C) * 2u; voffB = (unsigned)(Rb * g.ldb + C) * 2u; }
    const size_t dA = (size_t)64 * g.lda * 2, dB = (size_t)64 * g.ldb * 2;
    const size_t kstep = (size_t)(BK * 2);
    const size_t hstepA = (size_t)HALF * g.lda * 2, hstepB = (size_t)HALF * g.ldb * 2;
    const size_t tstepA = 2 * hstepA, tstepB = 2 * hstepB;
    const unsigned ldsw = (unsigned)wid * 1024u;
    const int aoff = lds_byte(wr * 64 + fr, fq * 8), boff = lds_byte(wc * 32 + fr, fq * 8);
#define PG8_SA(b, h) (((b) * 2 + (h)) * HTB)
#define PG8_SB(b, h) ((4 + (b) * 2 + (h)) * HTB)
#define PG8_STAGE(bufoff, gbase, voff) do { _Pragma("unroll") for (int _i = 0; _i < 2; ++_i) \
        __builtin_amdgcn_global_load_lds((const unsigned*)((const char*)(gbase) + (size_t)_i * PG8_D_##voff + (voff)), (LAS unsigned*)(lds + (bufoff) + ldsw + _i * 8192), 16, 0, 0); } while (0)
#define PG8_D_voffA dA
#define PG8_D_voffB dB
#define PG8_LDA(dst, b, h) do { _Pragma("unroll") for (int m = 0; m < 4; ++m) _Pragma("unroll") for (int k = 0; k < 2; ++k) dst[m][k] = *(const LAS bf16x8*)(lds + PG8_SA(b, h) + aoff + m * 2048 + k * 1024); } while (0)
#define PG8_LDB(dst, b, h) do { _Pragma("unroll") for (int n = 0; n < 2; ++n) _Pragma("unroll") for (int k = 0; k < 2; ++k) dst[n][k] = *(const LAS bf16x8*)(lds + PG8_SB(b, h) + boff + n * 2048 + k * 1024); } while (0)
#define PG8_MMA(ai, bj, At, Bt) do { __builtin_amdgcn_s_setprio(1); _Pragma("unroll") for (int m = 0; m < 4; ++m) _Pragma("unroll") for (int n = 0; n < 2; ++n) _Pragma("unroll") for (int k = 0; k < 2; ++k) \
        acc[ai][bj][m][n] = __builtin_amdgcn_mfma_f32_16x16x32_bf16(Bt[n][k], At[m][k], acc[ai][bj][m][n], 0, 0, 0); __builtin_amdgcn_s_setprio(0); } while (0)
#define PG8_WAIT_V(n) asm volatile("s_waitcnt vmcnt(" #n ")" ::: "memory")
#define PG8_WAIT_L(n) asm volatile("s_waitcnt lgkmcnt(" #n ")" ::: "memory")
#define PG8_BAR __builtin_amdgcn_s_barrier()
#define PG8_SCHED __builtin_amdgcn_sched_barrier(0)
    Unit cur, nxt; int ui = 0;
    if (!S.next(0, cur)) return;
    cur.pm = __builtin_amdgcn_readfirstlane(cur.pm); cur.pn = __builtin_amdgcn_readfirstlane(cur.pn);
    f32x4 acc[2][2][4][2];
#pragma unroll
    for (int a = 0; a < 2; ++a)
#pragma unroll
        for (int b = 0; b < 2; ++b)
#pragma unroll
            for (int m = 0; m < 4; ++m)
#pragma unroll
                for (int n = 0; n < 2; ++n) acc[a][b][m][n] = (f32x4){0.f, 0.f, 0.f, 0.f};
    bf16x8 At[4][2], B0[2][2], B1[2][2];
    const char* cA = (const char*)g.A + (size_t)cur.pm * tstepA;
    const char* cB = (const char*)g.Bt + (size_t)(cur.pm >> g.gm) * g.gstrideB + (size_t)cur.pn * tstepB;
    PG8_STAGE(PG8_SB(0, 0), cB, voffB); PG8_STAGE(PG8_SA(0, 0), cA, voffA); PG8_STAGE(PG8_SB(0, 1), cB + hstepB, voffB); PG8_STAGE(PG8_SA(0, 1), cA + hstepA, voffA);
    if (wr == 1) PG8_BAR;
    PG8_WAIT_V(4); PG8_BAR;
    PG8_STAGE(PG8_SB(1, 0), cB + kstep, voffB); PG8_STAGE(PG8_SA(1, 0), cA + kstep, voffA); PG8_STAGE(PG8_SB(1, 1), cB + hstepB + kstep, voffB);
    PG8_WAIT_V(6); PG8_BAR;
    for (;;) {
        const bool has_next = S.next(ui + 1, nxt);
        nxt.pm = __builtin_amdgcn_readfirstlane(nxt.pm); nxt.pn = __builtin_amdgcn_readfirstlane(nxt.pn);
        const char* nA = has_next ? (const char*)g.A + (size_t)nxt.pm * tstepA : cA;
        const char* nB = has_next ? (const char*)g.Bt + (size_t)(nxt.pm >> g.gm) * g.gstrideB + (size_t)nxt.pn * tstepB : cB;
        for (int t = 0; t < nt; t += 2) {
            const bool last = (t == nt - 2);
            const char* a1 = cA + (size_t)(t + 1) * kstep;
            const char* a2 = last ? nA : cA + (size_t)(t + 2) * kstep; const char* b2 = last ? nB : cB + (size_t)(t + 2) * kstep;
            const char* a3 = a2 + kstep; const char* b3 = b2 + kstep;
            PG8_LDB(B0, 0, 0); PG8_SCHED; PG8_LDA(At, 0, 0); PG8_STAGE(PG8_SA(1, 1), a1 + hstepA, voffA);
            PG8_WAIT_L(8); PG8_BAR; PG8_WAIT_L(0); PG8_MMA(0, 0, At, B0); PG8_BAR; PG8_SCHED;
            PG8_LDB(B1, 0, 1); PG8_STAGE(PG8_SB(0, 0), b2, voffB);
            PG8_BAR; PG8_WAIT_L(0); PG8_MMA(0, 1, At, B1); PG8_BAR;
            PG8_LDA(At, 0, 1); PG8_STAGE(PG8_SA(0, 0), a2, voffA);
            PG8_BAR; PG8_WAIT_L(0); PG8_MMA(1, 0, At, B0); PG8_BAR; PG8_SCHED;
            PG8_STAGE(PG8_SB(0, 1), b2 + hstepB, voffB);
            PG8_WAIT_V(6); PG8_BAR; PG8_MMA(1, 1, At, B1); PG8_BAR;
            PG8_LDB(B0, 1, 0); PG8_SCHED; PG8_LDA(At, 1, 0); PG8_STAGE(PG8_SA(0, 1), a2 + hstepA, voffA);
            PG8_WAIT_L(8); PG8_BAR; PG8_WAIT_L(0); PG8_MMA(0, 0, At, B0); PG8_BAR; PG8_SCHED;
            PG8_LDB(B1, 1, 1); PG8_STAGE(PG8_SB(1, 0), b3, voffB);
            PG8_BAR; PG8_WAIT_L(0); PG8_MMA(0, 1, At, B1); PG8_BAR;
            PG8_LDA(At, 1, 1); PG8_STAGE(PG8_SA(1, 0), a3, voffA);
            PG8_BAR; PG8_WAIT_L(0); PG8_MMA(1, 0, At, B0); PG8_BAR; PG8_SCHED;
            PG8_STAGE(PG8_SB(1, 1), b3 + hstepB, voffB);
            PG8_WAIT_V(6); PG8_BAR; PG8_MMA(1, 1, At, B1); PG8_BAR;
        }
        { const int l2 = otid() & 63; E(acc, cur, wr, wc, l2 & 15, l2 >> 4); }
        if (!has_next) break;
#pragma unroll
        for (int a = 0; a < 2; ++a)
#pragma unroll
            for (int b = 0; b < 2; ++b)
#pragma unroll
                for (int m = 0; m < 4; ++m)
#pragma unroll
                    for (int n = 0; n < 2; ++n) acc[a][b][m][n] = (f32x4){0.f, 0.f, 0.f, 0.f};
        cur = nxt; cA = nA; cB = nB; ++ui;
    }
    PG8_WAIT_V(0);
    if (wr == 0) PG8_BAR;
    PG8_BAR;
#undef PG8_SA
#undef PG8_SB
#undef PG8_STAGE
#undef PG8_D_voffA
#undef PG8_D_voffB
#undef PG8_LDA
#undef PG8_LDB
#undef PG8_MMA
#undef PG8_WAIT_V
#undef PG8_WAIT_L
#undef PG8_BAR
#undef PG8_SCHED
}
}
using pg8::Unit;

#define EPI_ROW(ai, m) (u.pm * 256 + (ai) * 128 + wr * 64 + (m) * 16 + fr)
typedef const f32x4 (&AccRef)[2][2][4][2];
__device__ __forceinline__ u32x4 pack8(f32x4 v0, f32x4 v1) { u32x4 w; w.x = cvt_pk_bf16(v0[0], v0[1]); w.y = cvt_pk_bf16(v0[2], v0[3]); w.z = cvt_pk_bf16(v1[0], v1[1]); w.w = cvt_pk_bf16(v1[2], v1[3]); return w; }

struct EpiIn {
    static constexpr bool PERM = true;
    bf16_t *R; const float* rstd1; const float* bias1;
    __device__ __forceinline__ void operator()(AccRef acc, const Unit& u, int wr, int wc, int fr, int fq) const {
        const int pn = u.pn, b = (u.pm * 256) >> 13;
        f32x4 bv[2][2];
#pragma unroll
        for (int bj = 0; bj < 2; ++bj)
#pragma unroll
            for (int n = 0; n < 2; ++n) bv[bj][n] = *(const f32x4*)(bias1 + b * DIN + pn * 256 + bj * 128 + wc * 32 + 8 * fq + 4 * n);
#pragma unroll
        for (int ai = 0; ai < 2; ++ai)
#pragma unroll
            for (int m = 0; m < 4; ++m) {
                const int row = EPI_ROW(ai, m); const float rs = rstd1[row];
#pragma unroll
                for (int bj = 0; bj < 2; ++bj) {
                    const u32x4 w = pack8(acc[ai][bj][m][0] * rs + bv[bj][0], acc[ai][bj][m][1] * rs + bv[bj][1]);
                    const int cl = bj * 128 + wc * 32 + 8 * fq;
                    size_t eo;
                    if (pn < 6) eo = (size_t)(pn >> 1) * (16u << 20) + (size_t)row * 512 + (pn & 1) * 256 + cl;
                    else if (pn == 6) eo = (WS_LO - WS_R) / 2 + (size_t)row * 256 + cl;
                    else { const int cu = (pn - 7) * 256 + cl, g = cu >> 4, ch = cu & 15; eo = (WS_USIN - WS_R) / 2 + ((size_t)(g * 2048 + (row >> 4)) * 384 + (row & 15) * 16 + ch); }
                    *(u32x4*)(R + eo) = w;
                }
            }
    }
};
struct EpiLora {
    static constexpr bool PERM = true;
    bf16_t* W; bf16_t* AA; bf16_t* G; const float* w0; const float* a0; int pn_off;
    static __device__ __forceinline__ float decay_of(float x) { return 0.6065306597126334f * sigmoidf_(x); }
    __device__ __forceinline__ void operator()(AccRef acc, const Unit& u, int wr, int wc, int fr, int fq) const {
        const int pnx = u.pn + pn_off, type = pnx >> 1, cb = (pnx & 1) * 256 + wc * 32 + 8 * fq;
        if (type == 0) {
#pragma unroll
            for (int bj = 0; bj < 2; ++bj) {
                const int c8 = cb + bj * 128; const f32x4 b0 = *(const f32x4*)(w0 + c8), b1 = *(const f32x4*)(w0 + c8 + 4);
#pragma unroll
                for (int ai = 0; ai < 2; ++ai)
#pragma unroll
                    for (int m = 0; m < 4; ++m) {
                        const int row = EPI_ROW(ai, m); f32x4 v0 = acc[ai][bj][m][0] + b0, v1 = acc[ai][bj][m][1] + b1;
#pragma unroll
                        for (int j = 0; j < 4; ++j) { v0[j] = decay_of(v0[j]); v1[j] = decay_of(v1[j]); }
                        *(u32x4*)(W + (size_t)row * 512 + c8) = pack8(v0, v1);
                    }
            }
        } else if (type == 1) {
#pragma unroll
            for (int bj = 0; bj < 2; ++bj) {
                const int c8 = cb + bj * 128; const f32x4 b0 = *(const f32x4*)(a0 + c8), b1 = *(const f32x4*)(a0 + c8 + 4);
#pragma unroll
                for (int ai = 0; ai < 2; ++ai)
#pragma unroll
                    for (int m = 0; m < 4; ++m) {
                        const int row = EPI_ROW(ai, m); f32x4 v0 = acc[ai][bj][m][0] + b0, v1 = acc[ai][bj][m][1] + b1;
#pragma unroll
                        for (int j = 0; j < 4; ++j) { v0[j] = sigmoidf_(v0[j]); v1[j] = sigmoidf_(v1[j]); }
                        *(u32x4*)(AA + (size_t)row * 512 + c8) = pack8(v0, v1);
                    }
            }
        } else {
#pragma unroll
            for (int bj = 0; bj < 2; ++bj)
#pragma unroll
                for (int ai = 0; ai < 2; ++ai)
#pragma unroll
                    for (int m = 0; m < 4; ++m) {
                        const int row = EPI_ROW(ai, m);
                        *(u32x4*)(G + (size_t)row * 512 + cb + bj * 128) = pack8(acc[ai][bj][m][0], acc[ai][bj][m][1]);
                    }
        }
    }
};
struct EpiS1 {
    static constexpr bool PERM = true;
    bf16_t* SLOC;
    __device__ __forceinline__ void operator()(AccRef acc, const Unit& u, int wr, int wc, int fr, int fq) const {
#pragma unroll
        for (int ai = 0; ai < 2; ++ai)
#pragma unroll
            for (int m = 0; m < 4; ++m) {
                const int row = EPI_ROW(ai, m);
                *(u32x4*)(SLOC + (size_t)row * 128 + wc * 32 + 8 * fq) = pack8(acc[ai][0][m][0], acc[ai][0][m][1]);
            }
    }
};
struct EpiS2 {
    static constexpr bool PERM = true;
    const bf16_t* USIN; bf16_t* ZZ; const float* dskip;
    __device__ __forceinline__ void operator()(AccRef acc, const Unit& u, int wr, int wc, int fr, int fq) const {
#pragma unroll
        for (int ai = 0; ai < 2; ++ai)
#pragma unroll
            for (int m = 0; m < 4; ++m) {
                const int row = EPI_ROW(ai, m), g = row >> 11, rig = row & 2047;
#pragma unroll
                for (int bj = 0; bj < 2; ++bj) {
                    const int col = bj * 128 + wc * 32 + 8 * fq, t = col >> 4, c = col & 15;
                    const u32x4 uu = *(const u32x4*)(USIN + (size_t)row * 384 + col);
                    const f32x4 d0 = *(const f32x4*)(dskip + g * 16 + c), d1 = *(const f32x4*)(dskip + g * 16 + c + 4);
                    f32x4 v0 = acc[ai][bj][m][0], v1 = acc[ai][bj][m][1];
                    v0[0] += d0[0] * bflo(uu.x); v0[1] += d0[1] * bfhi(uu.x); v0[2] += d0[2] * bflo(uu.y); v0[3] += d0[3] * bfhi(uu.y);
                    v1[0] += d1[0] * bflo(uu.z); v1[1] += d1[1] * bfhi(uu.z); v1[2] += d1[2] * bflo(uu.w); v1[3] += d1[3] * bfhi(uu.w);
#pragma unroll
                    for (int j = 0; j < 4; ++j) { v0[j] = gelu_tanh(v0[j]); v1[j] = gelu_tanh(v1[j]); }
                    *(u32x4*)(ZZ + (size_t)(rig * 16 + t) * 512 + g * 16 + c) = pack8(v0, v1);
                }
            }
    }
};
struct EpiGlu {
    static constexpr bool PERM = true;
    const bf16_t* ZZ; bf16_t* GLUO; const float* bglu; float* rss;
    __device__ __forceinline__ void operator()(AccRef acc, const Unit& u, int wr, int wc, int fr, int fq) const {
#pragma unroll
        for (int ai = 0; ai < 2; ++ai)
#pragma unroll
            for (int m = 0; m < 4; ++m) {
                const int row = EPI_ROW(ai, m); float ss = 0.f;
#pragma unroll
                for (int bj = 0; bj < 2; ++bj) {
                    const int col = u.pn * 256 + bj * 128 + wc * 32 + 8 * fq;
                    const u32x4 zz = *(const u32x4*)(ZZ + (size_t)row * 512 + col);
                    const f32x4 b0 = *(const f32x4*)(bglu + col), b1 = *(const f32x4*)(bglu + col + 4);
                    f32x4 v0 = acc[ai][bj][m][0] + b0, v1 = acc[ai][bj][m][1] + b1;
                    v0[0] = bflo(zz.x) * sigmoidf_(v0[0]); v0[1] = bfhi(zz.x) * sigmoidf_(v0[1]); v0[2] = bflo(zz.y) * sigmoidf_(v0[2]); v0[3] = bfhi(zz.y) * sigmoidf_(v0[3]);
                    v1[0] = bflo(zz.z) * sigmoidf_(v1[0]); v1[1] = bfhi(zz.z) * sigmoidf_(v1[1]); v1[2] = bflo(zz.w) * sigmoidf_(v1[2]); v1[3] = bfhi(zz.w) * sigmoidf_(v1[3]);
#pragma unroll
                    for (int j = 0; j < 4; ++j) ss += v0[j] * v0[j] + v1[j] * v1[j];
                    *(u32x4*)(GLUO + (size_t)row * 512 + col) = pack8(v0, v1);
                }
                ss += __shfl_xor(ss, 16); ss += __shfl_xor(ss, 32);
                if (fq == 0) rss[(size_t)row * 8 + u.pn * 4 + wc] = ss;
            }
    }
};
struct EpiOut {
    static constexpr bool PERM = true;
    const float* x; bf16_t* X1; bf16_t* A2; const float* ada; float* rss;
    __device__ __forceinline__ void operator()(AccRef acc, const Unit& u, int wr, int wc, int fr, int fq) const {
        const int b = (u.pm * 256) >> 13;
        const float* gm = ada + b * 6144 + 2048; const float* scf = ada + b * 6144 + 4096;
        f32x4 gv[2][2], sv[2][2];
#pragma unroll
        for (int bj = 0; bj < 2; ++bj)
#pragma unroll
            for (int n = 0; n < 2; ++n) { const int col = u.pn * 256 + bj * 128 + wc * 32 + 8 * fq + 4 * n; gv[bj][n] = *(const f32x4*)(gm + col); sv[bj][n] = *(const f32x4*)(scf + col) + 1.0f; }
#pragma unroll
        for (int ai = 0; ai < 2; ++ai)
#pragma unroll
            for (int m = 0; m < 4; ++m) {
                const int row = EPI_ROW(ai, m); float ss = 0.f;
#pragma unroll
                for (int bj = 0; bj < 2; ++bj) {
                    const size_t off = (size_t)row * 1024 + u.pn * 256 + bj * 128 + wc * 32 + 8 * fq;
                    const f32x4 x0 = ldnt((const f32x4*)(x + off)) + gv[bj][0] * acc[ai][bj][m][0];
                    const f32x4 x1 = ldnt((const f32x4*)(x + off + 4)) + gv[bj][1] * acc[ai][bj][m][1];
                    *(u32x4*)(X1 + off) = pack8(x0, x1);
                    ss += (x0[0] * x0[0] + x0[1] * x0[1] + x0[2] * x0[2] + x0[3] * x0[3]) + (x1[0] * x1[0] + x1[1] * x1[1] + x1[2] * x1[2] + x1[3] * x1[3]);
                    *(u32x4*)(A2 + off) = pack8(x0 * sv[bj][0], x1 * sv[bj][1]);
                }
                ss += __shfl_xor(ss, 16); ss += __shfl_xor(ss, 32);
                if (fq == 0) rss[(size_t)row * 16 + u.pn * 4 + wc] = ss;
            }
    }
};
struct EpiGU {
    static constexpr bool PERM = true;
    bf16_t* HMID; const float* rss2; const float* bias2;
    __device__ __forceinline__ void operator()(AccRef acc, const Unit& u, int wr, int wc, int fr, int fq) const {
        const int b = (u.pm * 256) >> 13;
        f32x4 bv[2][2];
#pragma unroll
        for (int bj = 0; bj < 2; ++bj)
#pragma unroll
            for (int n = 0; n < 2; ++n) bv[bj][n] = *(const f32x4*)(bias2 + b * 5632 + u.pn * 256 + bj * 128 + wc * 32 + 8 * fq + 4 * n);
#pragma unroll
        for (int ai = 0; ai < 2; ++ai)
#pragma unroll
            for (int m = 0; m < 4; ++m) {
                const int row = EPI_ROW(ai, m); const f32x4* rp = (const f32x4*)(rss2 + (size_t)row * 16); const f32x4 q4 = (rp[0] + rp[1]) + (rp[2] + rp[3]); const float rs = rsqrtf(((q4[0] + q4[1]) + (q4[2] + q4[3])) * (1.0f / 1024.0f) + 1e-6f);
                f32x4 h0, h1;
#pragma unroll
                for (int j = 0; j < 4; ++j) {
                    const float g0 = acc[ai][0][m][0][j] * rs + bv[0][0][j], u0 = acc[ai][1][m][0][j] * rs + bv[1][0][j];
                    const float g1 = acc[ai][0][m][1][j] * rs + bv[0][1][j], u1 = acc[ai][1][m][1][j] * rs + bv[1][1][j];
                    h0[j] = siluf_(g0) * u0; h1[j] = siluf_(g1) * u1;
                }
                *(u32x4*)(HMID + (size_t)row * DFF + u.pn * 128 + wc * 32 + 8 * fq) = pack8(h0, h1);
            }
    }
};
struct EpiDown {
    static constexpr bool PERM = true;
    const bf16_t* X1; bf16_t* out; const float* ada; float* rss;
    __device__ __forceinline__ void operator()(AccRef acc, const Unit& u, int wr, int wc, int fr, int fq) const {
        const int b = (u.pm * 256) >> 13;
        const float* gf = ada + b * 6144 + 5120;
        f32x4 gv[2][2];
#pragma unroll
        for (int bj = 0; bj < 2; ++bj)
#pragma unroll
            for (int n = 0; n < 2; ++n) gv[bj][n] = *(const f32x4*)(gf + u.pn * 256 + bj * 128 + wc * 32 + 8 * fq + 4 * n);
#pragma unroll
        for (int ai = 0; ai < 2; ++ai)
#pragma unroll
            for (int m = 0; m < 4; ++m) {
                const int row = EPI_ROW(ai, m); float ss = 0.f;
#pragma unroll
                for (int bj = 0; bj < 2; ++bj) {
                    const size_t off = (size_t)row * 1024 + u.pn * 256 + bj * 128 + wc * 32 + 8 * fq;
                    const u32x4 xb = ldnt((const u32x4*)(X1 + off));
                    const f32x4 x0 = (f32x4){bflo(xb.x), bfhi(xb.x), bflo(xb.y), bfhi(xb.y)} + gv[bj][0] * acc[ai][bj][m][0];
                    const f32x4 x1 = (f32x4){bflo(xb.z), bfhi(xb.z), bflo(xb.w), bfhi(xb.w)} + gv[bj][1] * acc[ai][bj][m][1];
                    *(u32x4*)(out + off) = pack8(x0, x1);
                    ss += (x0[0] * x0[0] + x0[1] * x0[1] + x0[2] * x0[2] + x0[3] * x0[3]) + (x1[0] * x1[0] + x1[1] * x1[1] + x1[2] * x1[2] + x1[3] * x1[3]);
                }
                ss += __shfl_xor(ss, 16); ss += __shfl_xor(ss, 32);
                if (fq == 0) rss[(size_t)row * 16 + u.pn * 4 + wc] = ss;
            }
    }
};

enum { I_X = 0, I_C, I_WADA, I_BADA, I_WIN, I_MU, I_W0, I_W2, I_A0, I_A2, I_G2, I_KK, I_KA, I_RK, I_LNW, I_LNB, I_SARE, I_SAIM, I_SLDT,
       I_SBRE, I_SBIM, I_SCRE, I_SCIM, I_SD, I_WGLU, I_BGLU, I_SGAIN, I_WOUT, I_FG, I_FU, I_FD, I_FGAIN };

template <class Map>
__device__ __forceinline__ void transpose_cvt(bf16_t* dst, const float* src, int Nd, int Kd, int ld, Map map, int gtid, int gthreads) {
    const int items = Nd * (Kd / 8);
    for (int it0 = gtid; it0 < items; it0 += 2 * gthreads) {
        float v[2][8];
#pragma unroll
        for (int u = 0; u < 2; ++u) { const int it = it0 + u * gthreads; if (it < items) { const int n = it % Nd, k8 = it / Nd; const int sc = map(n);
#pragma unroll
            for (int j = 0; j < 8; ++j) v[u][j] = src[(size_t)(k8 * 8 + j) * ld + sc]; } }
#pragma unroll
        for (int u = 0; u < 2; ++u) { const int it = it0 + u * gthreads; if (it < items) { const int n = it % Nd, k8 = it / Nd;
            u32x4 w; w.x = cvt_pk_bf16(v[u][0], v[u][1]); w.y = cvt_pk_bf16(v[u][2], v[u][3]); w.z = cvt_pk_bf16(v[u][4], v[u][5]); w.w = cvt_pk_bf16(v[u][6], v[u][7]);
            *(u32x4*)(dst + (size_t)n * Kd + k8 * 8) = w; } }
    }
}

__device__ __forceinline__ void s5_mats(const Params& p, int g, int part, LAS unsigned char* lds) {
    LAS float* ap_re = (LAS float*)lds;
    LAS float* ap_im = ap_re + 17 * 64;
    LAS float* bb_re = ap_im + 17 * 64;
    LAS float* bb_im = bb_re + 1024;
    LAS float* c_re = bb_im + 1024;
    LAS float* c_im = c_re + 1024;
    LAS float* ktab = c_im + 1024;
    const int tid = otid();
    const float dt = expf(p.in[I_SLDT][g]);
    const float* are_p = p.in[I_SARE] + g * 64; const float* aim_p = p.in[I_SAIM] + g * 64;
    for (int i = tid; i < 17 * 64; i += 512) { const int tau = i >> 6, pp = i & 63; const float mag = expf((float)tau * dt * are_p[pp]), ang = (float)tau * dt * aim_p[pp]; ap_re[i] = mag * cosf(ang); ap_im[i] = mag * sinf(ang); }
    for (int i = tid; i < 1024; i += 512) {
        const int pp = i >> 4;
        const float are = are_p[pp], aim = aim_p[pp], mag = expf(dt * are), abr = mag * cosf(dt * aim), abi = mag * sinf(dt * aim), den = are * are + aim * aim;
        const float pr = abr - 1.0f, q = abi, cre = (pr * are + q * aim) / den, cim = (q * are - pr * aim) / den;
        const float bre = p.in[I_SBRE][(size_t)g * 1024 + i], bim = p.in[I_SBIM][(size_t)g * 1024 + i];
        bb_re[i] = cre * bre - cim * bim; bb_im[i] = cre * bim + cim * bre;
        c_re[i] = p.in[I_SCRE][(size_t)g * 1024 + i]; c_im[i] = p.in[I_SCIM][(size_t)g * 1024 + i];
    }
    __syncthreads();
    {   const int i = tid, tau = i >> 5, cl = (i >> 4) & 1, cc = 2 * part + cl, c2 = i & 15; float s = 0.f;
        for (int pp = 0; pp < 64; ++pp) {
            const float cr = c_re[cc * 64 + pp], ci = c_im[cc * 64 + pp], ar = ap_re[tau * 64 + pp], ai = ap_im[tau * 64 + pp];
            const float xr = cr * ar - ci * ai, xi = cr * ai + ci * ar;
            s += xr * bb_re[pp * 16 + c2] - xi * bb_im[pp * 16 + c2];
        }
        ktab[i] = s; }
    __syncthreads();
    bf16_t* TV = (bf16_t*)(p.ws + WS_S5TV) + (size_t)g * 256 * 384;
    for (int i = tid; i < 32 * 384; i += 512) {
        const int rr = i / 384, kk = i % 384, t = rr >> 1, cl = rr & 1, cc = 2 * part + cl, n = t * 16 + cc; float val;
        if (kk < 256) { const int sx = kk >> 4, c2 = kk & 15; val = (sx <= t) ? ktab[(t - sx) * 32 + cl * 16 + c2] : 0.f; }
        else { const int q = kk - 256, pp = q & 63, tau = t + 1; const float cr = c_re[cc * 64 + pp], ci = c_im[cc * 64 + pp], ar = ap_re[tau * 64 + pp], ai = ap_im[tau * 64 + pp];
            val = (q < 64) ? (cr * ar - ci * ai) : -(cr * ai + ci * ar); }
        TV[(size_t)n * 384 + kk] = f2bf(val);
    }
    bf16_t* WG = (bf16_t*)(p.ws + WS_S5W) + (size_t)g * 256 * 256;
    for (int i = tid; i < 32 * 256; i += 512) {
        const int rr = i >> 8, kk = i & 255, sx = kk >> 4, c2 = kk & 15, n = (rr < 16) ? (16 * part + rr) : (128 + 16 * part + (rr - 16)); float val = 0.f;
        if (n < 128) { const int pp = n & 63, tau = 15 - sx; const float ar = ap_re[tau * 64 + pp], ai = ap_im[tau * 64 + pp], br = bb_re[pp * 16 + c2], bi = bb_im[pp * 16 + c2];
            val = (n < 64) ? (ar * br - ai * bi) : (ar * bi + ai * br); }
        WG[(size_t)n * 256 + kk] = f2bf(val);
    }
    __syncthreads();
}

__device__ __forceinline__ void phase0(const Params& p, LAS unsigned char* lds, bool do_ada) {
    const int tid = otid(), nblk = gridDim.x, blk = blockIdx.x;
    unsigned char* ws = p.ws;
    float* ada = (float*)(ws + WS_SMALL + SM_ADA);
    const int nada = (nblk >= 192) ? 96 : (nblk > 1 ? nblk / 2 : 1);
    if (blk < nada) {
        if (do_ada) {
            const int lane = tid & 63, wv = tid >> 6; LAS float* part = (LAS float*)lds;
            LAS float* sil = part + 2048;
            for (int i = tid; i < 4096; i += 512) sil[i] = siluf_(p.in[I_C][i]);
            __syncthreads();
            for (int cbk = blk; cbk < 96; cbk += nada) {
                const int col = cbk * 64 + lane; float a0 = 0.f, a1 = 0.f, a2 = 0.f, a3 = 0.f;
                const float* wp = p.in[I_WADA] + (size_t)(wv * 128) * 6144 + col; const LAS float* sp = sil + wv * 128;
                for (int k0 = 0; k0 < 128; k0 += 16) {
                    float w[16];
#pragma unroll
                    for (int j = 0; j < 16; ++j) w[j] = wp[(size_t)(k0 + j) * 6144];
#pragma unroll
                    for (int j = 0; j < 16; ++j) { a0 += sp[k0 + j] * w[j]; a1 += sp[1024 + k0 + j] * w[j]; a2 += sp[2048 + k0 + j] * w[j]; a3 += sp[3072 + k0 + j] * w[j]; }
                }
                __syncthreads();
                part[(wv * 4 + 0) * 64 + lane] = a0; part[(wv * 4 + 1) * 64 + lane] = a1; part[(wv * 4 + 2) * 64 + lane] = a2; part[(wv * 4 + 3) * 64 + lane] = a3;
                __syncthreads();
                if (tid < 256) { const int bb = tid >> 6; float sacc = p.in[I_BADA][col];
#pragma unroll
                    for (int w8 = 0; w8 < 8; ++w8) sacc += part[(w8 * 4 + bb) * 64 + lane];
                    ada[bb * 6144 + col] = sacc; }
            }
            __syncthreads();
        }
        if (nblk > nada) return;
    }
    const int tb_ = (nblk > nada) ? blk - nada : blk, tn_ = (nblk > nada) ? nblk - nada : nblk;
    const int gtid = tb_ * 512 + tid, gth = tn_ * 512;
    transpose_cvt((bf16_t*)(ws + WS_WIN_T), p.in[I_WIN], 2304, 1024, 2304, [](int n) { return n; }, gtid, gth);
}

__device__ __forceinline__ void late_weights(const Params& p, int gtid, int gth) {
    unsigned char* ws = p.ws;
    transpose_cvt((bf16_t*)(ws + WS_WOUT_T), p.in[I_WOUT], 1024, 1024, 1024, [](int n) { return n; }, gtid, gth);
    transpose_cvt((bf16_t*)(ws + WS_DOWN_T), p.in[I_FD], 1024, 2816, 1024, [](int n) { return n; }, gtid, gth);
    {
        bf16_t* dst = (bf16_t*)(ws + WS_GU_T);
        const int items = 5632 * 128;
        for (int it0 = gtid; it0 < items; it0 += 2 * gth) {
            float v[2][8];
#pragma unroll
            for (int u = 0; u < 2; ++u) { const int it = it0 + u * gth; if (it < items) { const int n = it % 5632, k8 = it / 5632, pn = n >> 8, wi = n & 255; const float* src = (wi < 128) ? p.in[I_FG] : p.in[I_FU]; const int sc = pn * 128 + (wi & 127);
#pragma unroll
                for (int j = 0; j < 8; ++j) v[u][j] = src[(size_t)(k8 * 8 + j) * DFF + sc]; } }
#pragma unroll
            for (int u = 0; u < 2; ++u) { const int it = it0 + u * gth; if (it < items) { const int n = it % 5632, k8 = it / 5632;
                u32x4 w; w.x = cvt_pk_bf16(v[u][0], v[u][1]); w.y = cvt_pk_bf16(v[u][2], v[u][3]); w.z = cvt_pk_bf16(v[u][4], v[u][5]); w.w = cvt_pk_bf16(v[u][6], v[u][7]);
                *(u32x4*)(dst + (size_t)n * 1024 + k8 * 8) = w; } }
        }
    }
}
__device__ __forceinline__ void late_bias2(const Params& p, int gw, int nw) {
    unsigned char* ws = p.ws; const int lane = otid() & 63;
    const float* ada = (const float*)(ws + WS_SMALL + SM_ADA); float* bias2 = (float*)(ws + WS_SMALL + SM_BIAS2);
    for (int n = gw; n < 5632; n += nw) {
        const bf16_t* wrow = (const bf16_t*)(ws + WS_GU_T) + (size_t)n * 1024;
        float a[4] = {0.f, 0.f, 0.f, 0.f};
#pragma unroll
        for (int i = 0; i < 2; ++i) {
            const int k0 = i * 512 + lane * 8; const u32x4 wv = *(const u32x4*)(wrow + k0);
            float wf[8]; unpack8(wv, wf);
#pragma unroll
            for (int b = 0; b < 4; ++b) { const float* sh = ada + b * 6144 + 3072 + k0;
#pragma unroll
                for (int j = 0; j < 8; ++j) a[b] += sh[j] * wf[j]; }
        }
#pragma unroll
        for (int b = 0; b < 4; ++b) a[b] = wave_sum(a[b]);
        if (lane == 0) {
#pragma unroll
            for (int b = 0; b < 4; ++b) bias2[b * 5632 + n] = a[b]; }
    }
}

__device__ __forceinline__ void deferred_setup(const Params& p, LAS unsigned char* lds, int bi, int nb) {
    unsigned char* ws = p.ws; const int tid = otid();
    for (int u = bi; u < NG * 8; u += nb) s5_mats(p, u >> 3, u & 7, lds);
    const int gtid = bi * 512 + tid, gth = nb * 512;
    transpose_cvt((bf16_t*)(ws + WS_WGLU_T), p.in[I_WGLU], 512, 512, 512, [](int n) { return n; }, gtid, gth);
    {
        bf16_t* dst = (bf16_t*)(ws + WS_LORA_T);
        const int items = 1536 * 32;
        for (int it = gtid; it < items; it += gth) {
            const int n = it % 1536, k8 = it / 1536, k0 = k8 * 8; float v[8];
#pragma unroll
            for (int j = 0; j < 8; ++j) { const int k = k0 + j; float x = 0.f;
                if (n < 512) { if (k < 64) x = p.in[I_W2][(size_t)k * 512 + n]; }
                else if (n < 1024) { if (k >= 64 && k < 128) x = p.in[I_A2][(size_t)(k - 64) * 512 + (n - 512)]; }
                else { if (k >= 128) x = p.in[I_G2][(size_t)(k - 128) * 512 + (n - 1024)]; }
                v[j] = x; }
            u32x4 w; w.x = cvt_pk_bf16(v[0], v[1]); w.y = cvt_pk_bf16(v[2], v[3]); w.z = cvt_pk_bf16(v[4], v[5]); w.w = cvt_pk_bf16(v[6], v[7]);
            *(u32x4*)(dst + (size_t)n * 256 + k0) = w;
        }
    }
}

__device__ __forceinline__ void phase1(const Params& p) {
    const int tid = otid(), lane = tid & 63, gw = blockIdx.x * 8 + (tid >> 6), nw = gridDim.x * 8;
    unsigned char* ws = p.ws;
    const float* ada = (const float*)(ws + WS_SMALL + SM_ADA);
    bf16_t* A1 = (bf16_t*)(ws + WS_A1); float* rstd1 = (float*)(ws + WS_SMALL + SM_RSTD1);
    for (int row0 = gw * 4; row0 < NT; row0 += nw * 4) {
        const int b = row0 >> 13; const float* sc = ada + b * 6144 + 1024;
        f32x4 xv[4][4];
#pragma unroll
        for (int r = 0; r < 4; ++r)
#pragma unroll
            for (int i = 0; i < 4; ++i) xv[r][i] = ldnt((const f32x4*)(p.in[I_X] + (size_t)(row0 + r) * 1024 + i * 256 + lane * 4));
        f32x4 sv[4];
#pragma unroll
        for (int i = 0; i < 4; ++i) sv[i] = *(const f32x4*)(sc + i * 256 + lane * 4) + 1.0f;
#pragma unroll
        for (int r = 0; r < 4; ++r) {
            float ss = 0.f;
#pragma unroll
            for (int i = 0; i < 4; ++i) ss += xv[r][i][0] * xv[r][i][0] + xv[r][i][1] * xv[r][i][1] + xv[r][i][2] * xv[r][i][2] + xv[r][i][3] * xv[r][i][3];
            ss = wave_sum(ss);
            if (lane == 0) rstd1[row0 + r] = rsqrtf(ss * (1.0f / 1024.0f) + 1e-6f);
#pragma unroll
            for (int i = 0; i < 4; ++i) { const f32x4 a = xv[r][i] * sv[i]; u32x2 w; w.x = cvt_pk_bf16(a[0], a[1]); w.y = cvt_pk_bf16(a[2], a[3]);
                *(u32x2*)(A1 + (size_t)(row0 + r) * 1024 + i * 256 + lane * 4) = w; }
        }
    }
    float* bias1 = (float*)(ws + WS_SMALL + SM_BIAS1); float* bias2 = (float*)(ws + WS_SMALL + SM_BIAS2);
    for (int it = gw; it < 2304; it += nw) {
        const bool first = it < 2304; const int n = first ? it : it - 2304;
        const bf16_t* wrow = first ? (const bf16_t*)(ws + WS_WIN_T) + (size_t)n * 1024 : (const bf16_t*)(ws + WS_GU_T) + (size_t)n * 1024;
        const int shoff = first ? 0 : 3072;
        float a[4] = {0.f, 0.f, 0.f, 0.f};
#pragma unroll
        for (int i = 0; i < 2; ++i) {
            const int k0 = i * 512 + lane * 8; const u32x4 wv = *(const u32x4*)(wrow + k0);
            const float wf[8] = {bflo(wv.x), bfhi(wv.x), bflo(wv.y), bfhi(wv.y), bflo(wv.z), bfhi(wv.z), bflo(wv.w), bfhi(wv.w)};
#pragma unroll
            for (int b = 0; b < 4; ++b) { const float* sh = ada + b * 6144 + shoff + k0;
#pragma unroll
                for (int j = 0; j < 8; ++j) a[b] += sh[j] * wf[j]; }
        }
#pragma unroll
        for (int b = 0; b < 4; ++b) a[b] = wave_sum(a[b]);
        if (lane == 0) { float* dst = first ? bias1 : bias2; const int ld = first ? 2304 : 5632;
#pragma unroll
            for (int b = 0; b < 4; ++b) dst[b * ld + n] = a[b]; }
    }
}

__device__ __forceinline__ void phase3(const Params& p) {
    const int gtid = blockIdx.x * 512 + otid(), gth = gridDim.x * 512;
    const bf16_t* LO = (const bf16_t*)(p.ws + WS_LO); bf16_t* LA = (bf16_t*)(p.ws + WS_LA); const float* mu = p.in[I_MU] + 1536;
    const int c0 = (gtid & 31) * 8;
    float m[8];
#pragma unroll
    for (int j = 0; j < 8; ++j) m[j] = mu[c0 + j];
    for (int base = gtid; base < NT * 32; base += 4 * gth) {
        u32x4 cur[4], prv[4];
#pragma unroll
        for (int k = 0; k < 4; ++k) { const int it = base + k * gth; cur[k] = (u32x4){0u, 0u, 0u, 0u}; prv[k] = (u32x4){0u, 0u, 0u, 0u};
            if (it < NT * 32) { const int t = it >> 5; cur[k] = ldnt((const u32x4*)(LO + (size_t)t * 256 + c0)); if ((t & (SEQ - 1)) != 0) prv[k] = *(const u32x4*)(LO + (size_t)(t - 1) * 256 + c0); } }
#pragma unroll
        for (int k = 0; k < 4; ++k) { const int it = base + k * gth;
            if (it < NT * 32) { const int t = it >> 5; float zc[8], zp[8], o[8]; unpack8(cur[k], zc); unpack8(prv[k], zp);
#pragma unroll
                for (int j = 0; j < 8; ++j) { const float z = zc[j] + m[j] * (zp[j] - zc[j]); o[j] = (c0 < 64) ? tanhf_(z) : (c0 < 128 ? z : sigmoidf_(z)); }
                *(u32x4*)(LA + (size_t)t * 256 + c0) = pack8a(o); } }
    }
}

__device__ __forceinline__ void s5_carry(const Params& p, int item) {
    const int lane = otid() & 63, g = item >> 2, b = item & 3;
    const float dt = expf(p.in[I_SLDT][g]); const float are = p.in[I_SARE][g * 64 + lane], aim = p.in[I_SAIM][g * 64 + lane];
    const float mag = expf(16.0f * dt * are), ang = 16.0f * dt * aim, ar = mag * cosf(ang), ai = mag * sinf(ang);
    const bf16_t* SLOC = (const bf16_t*)(p.ws + WS_SLOC); bf16_t* USIN = (bf16_t*)(p.ws + WS_USIN);
    float sr = 0.f, si = 0.f;
    const size_t r0 = (size_t)g * 2048 + b * 512;
    for (int c0 = 0; c0 < 512; c0 += 32) {
        unsigned short lr[32], li[32];
#pragma unroll
        for (int j = 0; j < 32; ++j) { lr[j] = SLOC[(r0 + c0 + j) * 128 + lane]; li[j] = SLOC[(r0 + c0 + j) * 128 + 64 + lane]; }
#pragma unroll
        for (int j = 0; j < 32; ++j) {
            bf16_t* dst = USIN + (r0 + c0 + j) * 384 + 256;
            dst[lane] = f2bf(sr); dst[64 + lane] = f2bf(si);
            const float nr = ar * sr - ai * si + bf2f(lr[j]), ni = ar * si + ai * sr + bf2f(li[j]);
            sr = nr; si = ni;
        }
    }
}

__device__ __forceinline__ void rwkv_prepass(const Params& p, int cidx) {
    const int lane = otid() & 63, c0 = lane * 8;
    unsigned char* ws = p.ws;
    const bf16_t* R = (const bf16_t*)(ws + WS_R); const bf16_t* K = (const bf16_t*)(ws + WS_K); const bf16_t* V = (const bf16_t*)(ws + WS_V);
    const bf16_t* W = (const bf16_t*)(ws + WS_W); const bf16_t* AA = (const bf16_t*)(ws + WS_AA);
    bf16_t* WR = (bf16_t*)(ws + WS_WR); bf16_t* KP = (bf16_t*)(ws + WS_KP); bf16_t* AL = (bf16_t*)(ws + WS_AL); bf16_t* BE = (bf16_t*)(ws + WS_BE); bf16_t* VS = (bf16_t*)(ws + WS_VS);
    f32x4* SC = (f32x4*)(ws + WS_SC);
    (void)cidx;
    float mur[8], muk[8], muv[8], kkc[8], kac[8], rkc[8];
#pragma unroll
    for (int j = 0; j < 8; ++j) { mur[j] = p.in[I_MU][c0 + j]; muk[j] = p.in[I_MU][512 + c0 + j]; muv[j] = p.in[I_MU][1024 + c0 + j]; kkc[j] = p.in[I_KK][c0 + j]; kac[j] = p.in[I_KA][c0 + j]; rkc[j] = p.in[I_RK][c0 + j]; }
    struct Row { u32x4 r, k, v, a, w; };
#define PRE_LD(d, t) do { const size_t e_ = (size_t)(t) * 512 + c0; d.r = ldnt((const u32x4*)(R + e_)); d.k = ldnt((const u32x4*)(K + e_)); d.v = ldnt((const u32x4*)(V + e_)); d.a = ldnt((const u32x4*)(AA + e_)); \
        d.w = *(const u32x4*)(W + e_); } while (0)
    const int gw_ = blockIdx.x * 8 + (otid() >> 6), nw_ = gridDim.x * 8;
    for (int it = gw_; it < NT / 8; it += nw_) {
        const int t0 = it * 8;
        float rp[8], kp[8], vp[8];
        if ((t0 & (SEQ - 1)) != 0) { const size_t e = (size_t)(t0 - 1) * 512 + c0; unpack8(*(const u32x4*)(R + e), rp); unpack8(*(const u32x4*)(K + e), kp); unpack8(*(const u32x4*)(V + e), vp); }
        else {
#pragma unroll
            for (int j = 0; j < 8; ++j) { rp[j] = 0.f; kp[j] = 0.f; vp[j] = 0.f; } }
        Row cur, nxt; PRE_LD(cur, t0);
#pragma unroll
        for (int tt = 0; tt < 8; ++tt) {
            const int t = t0 + tt;
            if (tt + 1 < 8) PRE_LD(nxt, t + 1);
            float rc[8], kc[8], vc[8], a[8]; unpack8(cur.r, rc); unpack8(cur.k, kc); unpack8(cur.v, vc); unpack8(cur.a, a);
            float w[8]; unpack8(cur.w, w);
#pragma unroll
            for (int j = 0; j < 8; ++j) w[j] = __expf(-w[j]);
            float r[8], k[8], v[8], kk[8], k2[8], be[8], o[8]; float ss = 0.f;
#pragma unroll
            for (int j = 0; j < 8; ++j) { r[j] = rc[j] + mur[j] * (rp[j] - rc[j]); k[j] = kc[j] + muk[j] * (kp[j] - kc[j]); v[j] = vc[j] + muv[j] * (vp[j] - vc[j]); kk[j] = k[j] * kkc[j]; ss += kk[j] * kk[j]; }
            ss = red8(ss); const float inv = 1.0f / fmaxf(sqrtf(ss), 1e-12f);
            float br = 0.f, kr = 0.f, bc = 0.f;
#pragma unroll
            for (int j = 0; j < 8; ++j) { kk[j] *= inv; k2[j] = k[j] * (1.0f + (a[j] - 1.0f) * kac[j]); be[j] = kk[j] * a[j]; br += be[j] * r[j]; kr += k2[j] * r[j]; bc += r[j] * k2[j] * rkc[j]; }
            br = red8(br); kr = red8(kr); bc = red8(bc);
            const size_t e = (size_t)t * 512 + c0;
#pragma unroll
            for (int j = 0; j < 8; ++j) o[j] = w[j] * r[j];
            *(u32x4*)(WR + e) = pack8a(o); *(u32x4*)(KP + e) = pack8a(k2);
#pragma unroll
            for (int j = 0; j < 8; ++j) o[j] = -kk[j];
            *(u32x4*)(AL + e) = pack8a(o); *(u32x4*)(VS + e) = pack8a(v);
            if ((lane & 7) == 0) SC[(size_t)t * 8 + (lane >> 3)] = (f32x4){br, kr, bc, 0.f};
#pragma unroll
            for (int j = 0; j < 8; ++j) { rp[j] = rc[j]; kp[j] = kc[j]; vp[j] = vc[j]; }
            cur = nxt;
        }
    }
#undef PRE_LD
}

constexpr int CH = 32;
constexpr int HSEQ = SEQ / 2;
constexpr int CB_AL = 0, CB_BE = 8192, CB_KP = 16384, CB_WR = 24576, CB_W = 32768, CB_VS = 40960, CB_Y = 49152, CB_BYTES = 53248;
struct ScanRegs { u32x4 al, be, kp, wr, w; f32x2 sca, scb; u32x4 vs; };
__device__ __forceinline__ void scan_load(const Params& p, ScanRegs& r, int lt, size_t tg0, int h, int row0, bool phi) {
    unsigned char* ws = p.ws;
    const int tok = lt >> 3, part = lt & 7; const size_t e = (tg0 + tok) * 512 + h * 64 + part * 8;
    r.al = *(const u32x4*)((const bf16_t*)(ws + WS_AL) + e); r.be = *(const u32x4*)((const bf16_t*)(ws + WS_AA) + e);
    r.kp = *(const u32x4*)((const bf16_t*)(ws + WS_KP) + e); r.wr = *(const u32x4*)((const bf16_t*)(ws + WS_WR) + e);
    r.w = *(const u32x4*)((const bf16_t*)(ws + WS_W) + e);
    { const f32x4 s4 = ((const f32x4*)(ws + WS_SC))[(tg0 + tok) * 8 + h]; r.sca = (f32x2){s4[0], s4[1]}; }
    if (lt < 4 * CH) { r.vs = (u32x4){0u, 0u, 0u, 0u}; const f32x4 s4 = ((const f32x4*)(ws + WS_SC))[(tg0 + (lt >> 2)) * 8 + h]; r.scb = (f32x2){s4[0], s4[1]};
        if (!phi) r.vs = *(const u32x4*)((const bf16_t*)(ws + WS_VS) + (tg0 + (lt >> 2)) * 512 + h * 64 + row0 + (lt & 3) * 8); }
}
__device__ __forceinline__ void st_bf8_f32(LAS unsigned char* dst, u32x4 v) {
    *(LAS f32x4*)dst = (f32x4){bflo(v.x), bfhi(v.x), bflo(v.y), bfhi(v.y)}; *(LAS f32x4*)(dst + 16) = (f32x4){bflo(v.z), bfhi(v.z), bflo(v.w), bfhi(v.w)};
}
__device__ __forceinline__ void scan_store(LAS unsigned char* buf, const ScanRegs& r, int lt) {
    const int o = (lt >> 3) * 256 + (lt & 7) * 32;
    st_bf8_f32(buf + CB_AL + o, r.al); st_bf8_f32(buf + CB_KP + o, r.kp);
    { float a8[8], g8[8]; unpack8(r.al, a8); unpack8(r.be, g8);
        *(LAS f32x4*)(buf + CB_BE + o) = (f32x4){-a8[0] * g8[0], -a8[1] * g8[1], -a8[2] * g8[2], -a8[3] * g8[3]}; *(LAS f32x4*)(buf + CB_BE + o + 16) = (f32x4){-a8[4] * g8[4], -a8[5] * g8[5], -a8[6] * g8[6], -a8[7] * g8[7]}; }
    { const float br = r.sca[0]; float a[8], wv[8]; unpack8(r.al, a); unpack8(r.wr, wv);
        *(LAS f32x4*)(buf + CB_WR + o) = (f32x4){wv[0] + br * a[0], wv[1] + br * a[1], wv[2] + br * a[2], wv[3] + br * a[3]};
        *(LAS f32x4*)(buf + CB_WR + o + 16) = (f32x4){wv[4] + br * a[4], wv[5] + br * a[5], wv[6] + br * a[6], wv[7] + br * a[7]}; }
    { float e8[8]; unpack8(r.w, e8);
        *(LAS f32x4*)(buf + CB_W + o) = (f32x4){__expf(-e8[0]), __expf(-e8[1]), __expf(-e8[2]), __expf(-e8[3])}; *(LAS f32x4*)(buf + CB_W + o + 16) = (f32x4){__expf(-e8[4]), __expf(-e8[5]), __expf(-e8[6]), __expf(-e8[7])}; }
    if (lt < 4 * CH) { LAS unsigned char* d = buf + CB_VS + (lt >> 2) * 256 + (lt & 3) * 64; const float kr = r.scb[1];
        float v[8]; unpack8(r.vs, v);
#pragma unroll
        for (int i = 0; i < 8; i += 2) *(LAS f32x4*)(d + i * 8) = (f32x4){v[i], v[i] * kr, v[i + 1], v[i + 1] * kr}; }
}
__device__ __forceinline__ void scan_yout(LAS unsigned char* buf, int tid, bf16_t* dst  ) {
    if (tid < 4 * CH) {
        const int tok = tid >> 2, qt = tid & 3;
        const f32x4 a = *(const LAS f32x4*)(buf + CB_Y + tok * 128 + qt * 32), b = *(const LAS f32x4*)(buf + CB_Y + tok * 128 + qt * 32 + 16);
        *(u32x4*)(dst + (size_t)tok * 512 + qt * 8) = pack8(a, b);
    }
}
__device__ __forceinline__ void rwkv_scan(const Params& p, int sb, LAS unsigned char* lds) {
    const int tid = otid(), wave = __builtin_amdgcn_readfirstlane(tid >> 6), lane = tid & 63;
    const int jj = sb >> 3, hh = (sb & 7) * 4 + jj / 6, role = jj % 6, b = hh >> 3, h = hh & 7, row0 = (role & 1) * 32, kind = role >> 1;
    const bool phi = (kind == 2);
    const size_t tg = (size_t)b * SEQ + (kind == 0 ? 0 : HSEQ);
    bf16_t* ydst = phi ? (bf16_t*)(p.ws + WS_YPHI) + ((size_t)b * HSEQ) * 512 + h * 64 + row0 : (bf16_t*)(p.ws + WS_Y) + tg * 512 + h * 64 + row0;
    constexpr int NCH = HSEQ / CH;
    const bool loader = wave >= 4; const int lt = tid - 256;
    ScanRegs rg;
    if (loader) { scan_load(p, rg, lt, tg, h, row0, phi); scan_store(lds, rg, lt); scan_load(p, rg, lt, tg + CH, h, row0, phi); }
    __syncthreads();
    const int rl = (wave & 3) * 8 + (lane >> 3), ko = lane & 7;
    float S[8];
#pragma unroll
    for (int i = 0; i < 8; ++i) S[i] = (phi && (row0 + rl == ko * 8 + i)) ? 1.f : 0.f;
    for (int c = 0; c < NCH; ++c) {
        LAS unsigned char* buf = lds + (c & 1) * CB_BYTES;
        LAS unsigned char* nb = lds + ((c + 1) & 1) * CB_BYTES;
        if (loader) {
            if (c > 0) scan_yout(nb, lt, ydst + (size_t)(c - 1) * CH * 512);
            if (c + 1 < NCH) scan_store(nb, rg, lt);
            if (c + 2 < NCH) scan_load(p, rg, lt, tg + (size_t)(c + 2) * CH, h, row0, phi);
        } else {
            __builtin_amdgcn_s_setprio(3);
            const LAS unsigned char* bq = buf + ko * 32;
            struct StepIn { f32x4 al0, al1, wq0, wq1, be0, be1, kp0, kp1, w0, w1; f32x2 rec; };
#define SCAN_LD(d, s) do { d.al0 = *(const LAS f32x4*)(bq + CB_AL + (s) * 256); d.al1 = *(const LAS f32x4*)(bq + CB_AL + (s) * 256 + 16); d.wq0 = *(const LAS f32x4*)(bq + CB_WR + (s) * 256); d.wq1 = *(const LAS f32x4*)(bq + CB_WR + (s) * 256 + 16); \
        d.be0 = *(const LAS f32x4*)(bq + CB_BE + (s) * 256); d.be1 = *(const LAS f32x4*)(bq + CB_BE + (s) * 256 + 16); d.kp0 = *(const LAS f32x4*)(bq + CB_KP + (s) * 256); d.kp1 = *(const LAS f32x4*)(bq + CB_KP + (s) * 256 + 16); \
        d.w0 = *(const LAS f32x4*)(bq + CB_W + (s) * 256); d.w1 = *(const LAS f32x4*)(bq + CB_W + (s) * 256 + 16); d.rec = *(const LAS f32x2*)(buf + CB_VS + (s) * 256 + rl * 8); } while (0)
            StepIn cur, n1;
            SCAN_LD(cur, 0);
#pragma unroll
            for (int s = 0; s < CH; ++s) {
                if (s + 1 < CH) SCAN_LD(n1, s + 1);
                const float al[8] = {cur.al0[0], cur.al0[1], cur.al0[2], cur.al0[3], cur.al1[0], cur.al1[1], cur.al1[2], cur.al1[3]};
                const float wq[8] = {cur.wq0[0], cur.wq0[1], cur.wq0[2], cur.wq0[3], cur.wq1[0], cur.wq1[1], cur.wq1[2], cur.wq1[3]};
                const float be[8] = {cur.be0[0], cur.be0[1], cur.be0[2], cur.be0[3], cur.be1[0], cur.be1[1], cur.be1[2], cur.be1[3]};
                const float kp[8] = {cur.kp0[0], cur.kp0[1], cur.kp0[2], cur.kp0[3], cur.kp1[0], cur.kp1[1], cur.kp1[2], cur.kp1[3]};
                const float w[8] = {cur.w0[0], cur.w0[1], cur.w0[2], cur.w0[3], cur.w1[0], cur.w1[1], cur.w1[2], cur.w1[3]};
                f32x2 t0 = (f32x2){S[0], S[1]} * (f32x2){al[0], al[1]}, t1 = (f32x2){S[0], S[1]} * (f32x2){wq[0], wq[1]};
#pragma unroll
                for (int i = 2; i < 8; i += 2) { t0 = (f32x2){S[i], S[i + 1]} * (f32x2){al[i], al[i + 1]} + t0; t1 = (f32x2){S[i], S[i + 1]} * (f32x2){wq[i], wq[i + 1]} + t1; }
                const float sa = red8(t0[0] + t0[1]);
                const float y = red8(t1[0] + t1[1]) + cur.rec[1];
                const f32x2 sa2 = (f32x2){sa, sa}, vv2 = (f32x2){cur.rec[0], cur.rec[0]};
#pragma unroll
                for (int i = 0; i < 8; i += 2) { const f32x2 sn = (f32x2){S[i], S[i + 1]} * (f32x2){w[i], w[i + 1]} + sa2 * (f32x2){be[i], be[i + 1]} + vv2 * (f32x2){kp[i], kp[i + 1]}; S[i] = sn[0]; S[i + 1] = sn[1]; }
                *(LAS float*)(buf + CB_Y + s * 128 + rl * 4) = y;
                cur = n1;
            }
#undef SCAN_LD
            __builtin_amdgcn_s_setprio(0);
        }
        __syncthreads();
    }
    if (loader) scan_yout(lds + ((NCH - 1) & 1) * CB_BYTES, lt, ydst + (size_t)(NCH - 1) * CH * 512);
    if (kind == 0 && wave < 4) { float* d = (float*)(p.ws + WS_SH) + ((size_t)hh * 64 + row0 + rl) * 64 + ko * 8;
        *(f32x4*)d = (f32x4){S[0], S[1], S[2], S[3]}; *(f32x4*)(d + 4) = (f32x4){S[4], S[5], S[6], S[7]}; }
    __syncthreads();
}
typedef float f32x16 __attribute__((ext_vector_type(16)));
__device__ __forceinline__ void rwkv_fixup(const Params& p) {
    const int tid = otid(), lane = tid & 63, gw = blockIdx.x * 8 + (tid >> 6), nw = gridDim.x * 8, r = lane & 31, hf = lane >> 5;
    const bf16_t* YPHI = (const bf16_t*)(p.ws + WS_YPHI); const float* SH = (const float*)(p.ws + WS_SH); bf16_t* Y = (bf16_t*)(p.ws + WS_Y);
    for (int u = gw; u < 32 * (HSEQ / 32); u += nw) {
        const int hh = u / (HSEQ / 32), tile = u % (HSEQ / 32), b = hh >> 3, h = hh & 7;
        const size_t tphi = (size_t)b * HSEQ + tile * 32, t0 = (size_t)b * SEQ + HSEQ + tile * 32;
        bf16x8 af[4];
#pragma unroll
        for (int s = 0; s < 4; ++s) af[s] = *(const bf16x8*)(YPHI + (tphi + r) * 512 + h * 64 + 16 * s + 8 * hf);
#pragma unroll
        for (int vt = 0; vt < 2; ++vt) {
            const float* srow = SH + ((size_t)hh * 64 + vt * 32 + r) * 64;
            f32x16 acc;
#pragma unroll
            for (int i = 0; i < 16; ++i) acc[i] = 0.f;
#pragma unroll
            for (int s = 0; s < 4; ++s) {
                const f32x4 x0 = *(const f32x4*)(srow + 16 * s + 8 * hf), x1 = *(const f32x4*)(srow + 16 * s + 8 * hf + 4);
                const u32x4 w = pack8(x0, x1); bf16x8 bfr = __builtin_bit_cast(bf16x8, w);
                acc = __builtin_amdgcn_mfma_f32_32x32x16_bf16(af[s], bfr, acc, 0, 0, 0);
            }
#pragma unroll
            for (int i = 0; i < 16; ++i) {
                const int row = (i & 3) + 8 * (i >> 2) + 4 * hf;
                bf16_t* yp = Y + (t0 + row) * 512 + h * 64 + vt * 32 + r;
                *yp = f2bf(bf2f(*yp) + acc[i]);
            }
        }
    }
}

__device__ __forceinline__ void phase8(const Params& p) {
    const int tid = otid(), lane = tid & 63, c0 = lane * 8, gw = blockIdx.x * 8 + (tid >> 6), nw = gridDim.x * 8;
    unsigned char* ws = p.ws;
    const bf16_t* Y = (const bf16_t*)(ws + WS_Y); const bf16_t* VS = (const bf16_t*)(ws + WS_VS); const bf16_t* G = (const bf16_t*)(ws + WS_G); const bf16_t* GLUO = (const bf16_t*)(ws + WS_GLUO);
    const f32x4* SC = (const f32x4*)(ws + WS_SC);
    bf16_t* MIX = (bf16_t*)(ws + WS_MIX);
    float lnw[8], lnb[8];
#pragma unroll
    for (int j = 0; j < 8; ++j) { lnw[j] = p.in[I_LNW][c0 + j]; lnb[j] = p.in[I_LNB][c0 + j]; }
    struct Row { u32x4 y, v, g; f32x4 sc; };
#define P8_LD(d, t) do { const size_t e_ = (size_t)(t) * 512 + c0; d.y = ldnt((const u32x4*)(Y + e_)); d.v = ldnt((const u32x4*)(VS + e_)); d.g = ldnt((const u32x4*)(G + e_)); \
        d.sc = SC[(size_t)(t) * 8 + (lane >> 3)]; } while (0)
    const int per = (NT + nw - 1) / nw, tbeg = gw * per, tend = (tbeg + per < NT) ? tbeg + per : NT;
    if (tbeg >= NT) return;
    Row cur, nxt; P8_LD(cur, tbeg);
    for (int t = tbeg; t < tend; ++t) {
        if (t + 1 < tend) P8_LD(nxt, t + 1);
        float y[8], v[8], g[8], o[8]; unpack8(cur.y, y); unpack8(cur.v, v); unpack8(cur.g, g);
        float sm = 0.f;
#pragma unroll
        for (int j = 0; j < 8; ++j) sm += y[j];
        const float mean = red8(sm) * (1.0f / 64.0f); float sq = 0.f;
#pragma unroll
        for (int j = 0; j < 8; ++j) { y[j] -= mean; sq += y[j] * y[j]; }
        const float rstd = rsqrtf(red8(sq) * (1.0f / 64.0f) + 64e-5f), bc = cur.sc[2];
#pragma unroll
        for (int j = 0; j < 8; ++j) o[j] = (y[j] * rstd * lnw[j] + lnb[j] + bc * v[j]) * g[j];
        *(u32x4*)(MIX + (size_t)t * 1024 + c0) = pack8a(o);
        cur = nxt;
    }
#undef P8_LD
}

__device__ __forceinline__ void s5_mix_half(const Params& p, int b2, int G2) {
    const int tid = otid(), lane = tid & 63, c0 = lane * 8, gw = b2 * 8 + (tid >> 6), nw = G2 * 8;
    const bf16_t* GLUO = (const bf16_t*)(p.ws + WS_GLUO); const float* rss5 = (const float*)(p.ws + WS_SMALL + SM_RSP5); bf16_t* MIX = (bf16_t*)(p.ws + WS_MIX);
    float gain[8];
#pragma unroll
    for (int j = 0; j < 8; ++j) gain[j] = p.in[I_SGAIN][c0 + j];
    for (int t0 = gw * 4; t0 < NT; t0 += nw * 4) {
        u32x4 gv[4]; float rs[4];
#pragma unroll
        for (int k = 0; k < 4; ++k) { gv[k] = *(const u32x4*)(GLUO + (size_t)(t0 + k) * 512 + c0); const f32x4* rp = (const f32x4*)(rss5 + (size_t)(t0 + k) * 8); const f32x4 q4 = rp[0] + rp[1]; rs[k] = rsqrtf(((q4[0] + q4[1]) + (q4[2] + q4[3])) * (1.0f / 512.0f) + 1e-6f); }
#pragma unroll
        for (int k = 0; k < 4; ++k) { float o[8]; unpack8(gv[k], o);
#pragma unroll
            for (int j = 0; j < 8; ++j) o[j] = o[j] * rs[k] * gain[j];
            *(u32x4*)(MIX + (size_t)(t0 + k) * 1024 + 512 + c0) = pack8a(o); }
    }
}

__device__ __forceinline__ void phase12(const Params& p) {
    const int tid = otid(), lane = tid & 63, gw = blockIdx.x * 8 + (tid >> 6), nw = gridDim.x * 8;
    const float* rss3 = (const float*)(p.ws + WS_RSP3); const bf16_t* X2 = (const bf16_t*)(p.ws + WS_X2B);
    f32x4 g[4];
#pragma unroll
    for (int i = 0; i < 4; ++i) g[i] = *(const f32x4*)(p.in[I_FGAIN] + i * 256 + lane * 4);
    for (int row0 = gw * 2; row0 < NT; row0 += nw * 2) {
        u32x2 xb[2][4]; float rs[2];
#pragma unroll
        for (int r = 0; r < 2; ++r) { const f32x4* rp = (const f32x4*)(rss3 + (size_t)(row0 + r) * 16); const f32x4 q4 = (rp[0] + rp[1]) + (rp[2] + rp[3]); rs[r] = rsqrtf(((q4[0] + q4[1]) + (q4[2] + q4[3])) * (1.0f / 1024.0f) + 1e-6f);
#pragma unroll
            for (int i = 0; i < 4; ++i) xb[r][i] = ldnt((const u32x2*)(X2 + (size_t)(row0 + r) * 1024 + i * 256 + lane * 4)); }
#pragma unroll
        for (int r = 0; r < 2; ++r)
#pragma unroll
            for (int i = 0; i < 4; ++i) { const f32x4 v = (f32x4){bflo(xb[r][i].x), bfhi(xb[r][i].x), bflo(xb[r][i].y), bfhi(xb[r][i].y)};
                stnt((f32x4*)(p.out + (size_t)(row0 + r) * 1024 + i * 256 + lane * 4), v * rs[r] * g[i]); }
    }
}

__device__ __forceinline__ void fast_barrier(unsigned* ctr, unsigned target, unsigned ep) {
    asm volatile("s_waitcnt vmcnt(0) lgkmcnt(0)" ::: "memory");
    __syncthreads();
    if (otid() == 0) {
        __builtin_amdgcn_fence(__ATOMIC_RELEASE, "agent");
        asm volatile("s_waitcnt vmcnt(0)" ::: "memory");
        const unsigned old = __hip_atomic_fetch_add(ctr, 1u, __ATOMIC_RELAXED, __HIP_MEMORY_SCOPE_AGENT);
        if (old + 1u == target) __hip_atomic_store(ctr + 64, ep, __ATOMIC_RELAXED, __HIP_MEMORY_SCOPE_AGENT);
        else while (__hip_atomic_load(ctr + 64, __ATOMIC_RELAXED, __HIP_MEMORY_SCOPE_AGENT) < ep) __builtin_amdgcn_s_sleep(1);
        __builtin_amdgcn_fence(__ATOMIC_ACQUIRE, "agent");
        asm volatile("s_waitcnt vmcnt(0)" ::: "memory");
    }
    __syncthreads();
}
__device__ __attribute__((noinline)) void gsync() { cg::this_grid().sync(); }
__global__ void __launch_bounds__(512) fwd_megakernel(Params p_arg) {
    const Params& p = *(const Params*)__builtin_amdgcn_kernarg_segment_ptr();
    extern __shared__ __attribute__((aligned(16))) unsigned char lds_raw[];
    LAS unsigned char* lds = (LAS unsigned char*)lds_raw;
    unsigned char* ws = p.ws;
    const int G = gridDim.x, blk = blockIdx.x;
    float* ada = (float*)(ws + WS_SMALL + SM_ADA);
    unsigned gep = 0; unsigned* gctr = (unsigned*)(ws + WS_SMALL + SM_CTR) + 256;
#define GBAR() do { ++gep; fast_barrier(gctr, gep * (unsigned)G, gep); } while (0)

    if (gridDim.x == 0x7fffffffu) gsync();
    REP(0) { phase0(p, lds, rep_ == 0); GBAR(); }
    REP(1) { phase1(p); GBAR(); }
    REP(2) {
        pg8::Gemm g{(const bf16_t*)(ws + WS_A1), (const bf16_t*)(ws + WS_WIN_T), NT, DIN, 1024, 1024, 1024, 30, 0};
        pg8::StaticOrder S; S.init(NT, DIN, G, blk);
        EpiIn E{(bf16_t*)(ws + WS_R), (const float*)(ws + WS_SMALL + SM_RSTD1), (const float*)(ws + WS_SMALL + SM_BIAS1)};
        pg8::gemm_phase(lds, g, S, E);
        {   const int nun = (NT / 256) * (DIN / 256), rem = nun % G;
            if (rep_ == 0) { if (rem == 0) deferred_setup(p, lds, blk, G); else if (blk >= rem) deferred_setup(p, lds, blk - rem, G - rem); } }
        GBAR();
    }
    REP(3) { phase3(p); GBAR(); }
    REP(4) {
        pg8::Gemm g{(const bf16_t*)(ws + WS_LA), (const bf16_t*)(ws + WS_LORA_T), NT, 1024, 256, 256, 256, 30, 0};
        pg8::StaticOrder S; S.init(NT, 1024, G, blk);
        EpiLora E{(bf16_t*)(ws + WS_W), (bf16_t*)(ws + WS_AA), (bf16_t*)(ws + WS_G), p.in[I_W0], p.in[I_A0], 0};
        pg8::gemm_phase(lds, g, S, E);
        GBAR();
    }
    REP(5) { rwkv_prepass(p, rep_); GBAR(); }
    REP(7) {
        const int nsc = (G >= 256) ? 192 : (G * 3) / 4;
        if (blk < nsc) { for (int sb = blk; sb < 192; sb += nsc) rwkv_scan(p, sb, lds); }
        else if (rep_ == 0) {
            const int G2 = G - nsc, b2 = blk - nsc; unsigned* sctr = (unsigned*)(ws + WS_SMALL + SM_CTR) + 512;
            {   pg8::Gemm g2{(const bf16_t*)(ws + WS_USIN), (const bf16_t*)(ws + WS_S5W), 65536, 256, 256, 384, 256, 3, (size_t)256 * 256 * 2};
                pg8::StaticOrder S2; S2.init(65536, 256, G2, b2);
                EpiS1 E2{(bf16_t*)(ws + WS_SLOC)};
                pg8::gemm_phase(lds, g2, S2, E2); }
            fast_barrier(sctr, (unsigned)G2, 1u);
            for (int it = b2 + (otid() >> 6) * G2; it < 128; it += 8 * G2) s5_carry(p, it);
            fast_barrier(sctr, 2u * (unsigned)G2, 2u);
            {   pg8::Gemm g{(const bf16_t*)(ws + WS_USIN), (const bf16_t*)(ws + WS_S5TV), 65536, 256, 384, 384, 384, 3, (size_t)256 * 384 * 2};
                pg8::StaticOrder S; S.init(65536, 256, G2, b2);
                EpiS2 E{(const bf16_t*)(ws + WS_USIN), (bf16_t*)(ws + WS_ZZ), p.in[I_SD]};
                pg8::gemm_phase(lds, g, S, E); }
            fast_barrier(sctr, 3u * (unsigned)G2, 3u);
            {   pg8::Gemm g{(const bf16_t*)(ws + WS_ZZ), (const bf16_t*)(ws + WS_WGLU_T), NT, 512, 512, 512, 512, 30, 0};
                pg8::StaticOrder S; S.init(NT, 512, G2, b2);
                EpiGlu E{(const bf16_t*)(ws + WS_ZZ), (bf16_t*)(ws + WS_GLUO), p.in[I_BGLU], (float*)(ws + WS_SMALL + SM_RSP5)};
                pg8::gemm_phase(lds, g, S, E); }
            fast_barrier(sctr, 4u * (unsigned)G2, 4u);
            s5_mix_half(p, b2, G2);
            {   pg8::Gemm g{(const bf16_t*)(ws + WS_LA), (const bf16_t*)(ws + WS_LORA_T) + (size_t)1024 * 256, NT, 512, 256, 256, 256, 30, 0};
                pg8::StaticOrder S; S.init(NT, 512, G2, b2);
                EpiLora E{(bf16_t*)(ws + WS_W), (bf16_t*)(ws + WS_AA), (bf16_t*)(ws + WS_G), p.in[I_W0], p.in[I_A0], 4};
                pg8::gemm_phase(lds, g, S, E); }
            late_weights(p, b2 * 512 + otid(), G2 * 512);
            fast_barrier(sctr, 5u * (unsigned)G2, 5u);
            late_bias2(p, b2 * 8 + (otid() >> 6), G2 * 8);
        }
        GBAR();
    }
    REP(13) { rwkv_fixup(p); GBAR(); }
    REP(8) { phase8(p); GBAR(); }
    REP(9) {
        pg8::Gemm g{(const bf16_t*)(ws + WS_MIX), (const bf16_t*)(ws + WS_WOUT_T), NT, 1024, 1024, 1024, 1024, 30, 0};
        pg8::StaticOrder S; S.init(NT, 1024, G, blk);
        EpiOut E{p.in[I_X], (bf16_t*)(ws + WS_X1), (bf16_t*)(ws + WS_A2), ada, (float*)(ws + WS_SMALL + SM_RSP2)};
        pg8::gemm_phase(lds, g, S, E);
        GBAR();
    }
    REP(10) {
        pg8::Gemm g{(const bf16_t*)(ws + WS_A2), (const bf16_t*)(ws + WS_GU_T), NT, 5632, 1024, 1024, 1024, 30, 0};
        pg8::StaticOrder S; S.init(NT, 5632, G, blk);
        EpiGU E{(bf16_t*)(ws + WS_HMID), (const float*)(ws + WS_SMALL + SM_RSP2), (const float*)(ws + WS_SMALL + SM_BIAS2)};
        pg8::gemm_phase(lds, g, S, E);
        GBAR();
    }
    REP(11) {
        pg8::Gemm g{(const bf16_t*)(ws + WS_HMID), (const bf16_t*)(ws + WS_DOWN_T), NT, 1024, DFF, DFF, DFF, 30, 0};
        pg8::StaticOrder S; S.init(NT, 1024, G, blk);
        EpiDown E{(const bf16_t*)(ws + WS_X1), (bf16_t*)(ws + WS_X2B), ada, (float*)(ws + WS_RSP3)};
        pg8::gemm_phase(lds, g, S, E);
        GBAR();
    }
    phase12(p);
}

extern "C" void kernel_launch(void* const* d_in, const int* in_sizes, int n_in, void* d_out, int out_size, void* d_ws, size_t ws_size, hipStream_t stream) {
    constexpr int LDS_BYTES = pg8::STAGE_BYTES;
    static int grid_blocks = 0;
    if (!grid_blocks) {
        int dev = 0, cus = 0, per_cu = 0;
        hipGetDevice(&dev);
        hipDeviceGetAttribute(&cus, hipDeviceAttributeMultiprocessorCount, dev);
        hipFuncSetAttribute((const void*)fwd_megakernel, hipFuncAttributeMaxDynamicSharedMemorySize, LDS_BYTES);
        hipOccupancyMaxActiveBlocksPerMultiprocessor(&per_cu, (const void*)fwd_megakernel, 512, LDS_BYTES);
        if (per_cu < 1) per_cu = 1;
        if (per_cu > 1) per_cu = 1;
        grid_blocks = cus * per_cu;
        if (ws_size < WS_END) fprintf(stderr, "kernel_launch: workspace too small: %zu < %zu\n", ws_size, (size_t)WS_END);
        (void)hipGetLastError();
    }
    hipMemsetAsync((unsigned char*)d_ws + WS_SMALL, 0, ZERO_BYTES, stream);
    Params p{};
    for (int i = 0; i < 32; ++i) p.in[i] = (const float*)d_in[i];
    p.out = (float*)d_out; p.ws = (unsigned char*)d_ws;
    void* args[] = {&p};
    hipError_t e = hipLaunchCooperativeKernel((const void*)fwd_megakernel, dim3(grid_blocks), dim3(512), args, LDS_BYTES, stream);
    if (e != hipSuccess) fprintf(stderr, "cooperative launch failed: %s (grid %d)\n", hipGetErrorString(e), grid_blocks);
}
```

```cpp
#include <hip/hip_runtime.h>
#include <hip/hip_cooperative_groups.h>
#include <cstdio>
#include <cstdint>
namespace cg = cooperative_groups;

#define LAS __attribute__((address_space(3)))
typedef unsigned short bf16_t;
typedef short bf16x8 __attribute__((ext_vector_type(8)));
typedef float f32x4 __attribute__((ext_vector_type(4)));
typedef float f32x2 __attribute__((ext_vector_type(2)));
typedef unsigned u32x4 __attribute__((ext_vector_type(4)));
typedef unsigned u32x2 __attribute__((ext_vector_type(2)));

constexpr int NT = 32768, SEQ = 8192, NB = 4, DM = 1024, DIN = 2304, DFF = 2816, NH = 8, NG = 32;
constexpr size_t MiB = 1ull << 20;
constexpr size_t WS_WIN_T = 0;
constexpr size_t WS_LORA_T = WS_WIN_T + (size_t)2304 * 1024 * 2;
constexpr size_t WS_WGLU_T = WS_LORA_T + (size_t)1536 * 256 * 2;
constexpr size_t WS_WOUT_T = WS_WGLU_T + (size_t)512 * 512 * 2;
constexpr size_t WS_GU_T = WS_WOUT_T + (size_t)1024 * 1024 * 2;
constexpr size_t WS_DOWN_T = WS_GU_T + (size_t)5632 * 1024 * 2;
constexpr size_t WS_S5W = WS_DOWN_T + (size_t)1024 * 2816 * 2;
constexpr size_t WS_S5TV = WS_S5W + (size_t)32 * 256 * 256 * 2;
constexpr size_t WS_WEND = WS_S5TV + (size_t)32 * 256 * 384 * 2;
static_assert(WS_WEND <= 36 * MiB, "weights region");
constexpr size_t WS_SMALL = 36 * MiB;
constexpr size_t SM_CTR = 0;
constexpr size_t ZERO_BYTES = 4096;
constexpr size_t SM_ADA = ZERO_BYTES;
constexpr size_t SM_BIAS1 = SM_ADA + 4 * 6144 * 4;
constexpr size_t SM_BIAS2 = SM_BIAS1 + 4 * 2304 * 4;
constexpr size_t SM_RSTD1 = SM_BIAS2 + 4 * 5632 * 4;
constexpr size_t SM_RSP5 = SM_RSTD1 + NT * 4;
constexpr size_t SM_RSP2 = SM_RSP5 + (size_t)NT * 8 * 4;
constexpr size_t SM_END = SM_RSP2 + (size_t)NT * 16 * 4;
static_assert(SM_END <= 4 * MiB, "small region");
constexpr size_t WS_A1 = 40 * MiB;
constexpr size_t WS_WR = 40 * MiB;
constexpr size_t WS_KP = 72 * MiB;
constexpr size_t WS_MIX = 200 * MiB;
constexpr size_t WS_R = 104 * MiB;
constexpr size_t WS_K = 136 * MiB;
constexpr size_t WS_V = 168 * MiB;
constexpr size_t WS_YPHI = 104 * MiB;
constexpr size_t WS_SH = 120 * MiB;
constexpr size_t WS_ZZ = 136 * MiB;
constexpr size_t WS_GLUO = 168 * MiB;
constexpr size_t WS_LO = 200 * MiB;
constexpr size_t WS_SLOC = 200 * MiB;
constexpr size_t WS_USIN = 216 * MiB;
constexpr size_t WS_LA = 264 * MiB;
constexpr size_t WS_W = 280 * MiB;
constexpr size_t WS_AA = 344 * MiB;
constexpr size_t WS_Y = 344 * MiB;
constexpr size_t WS_G = 376 * MiB;
constexpr size_t WS_AL = 408 * MiB;
constexpr size_t WS_BE = 440 * MiB;
constexpr size_t WS_VS = 472 * MiB;
constexpr size_t WS_SC = 504 * MiB;
constexpr size_t WS_X1 = 104 * MiB;
constexpr size_t WS_X2B = 168 * MiB;
constexpr size_t WS_A2 = 40 * MiB;
constexpr size_t WS_HMID = 296 * MiB;
constexpr size_t WS_RSP3 = 508 * MiB;
constexpr size_t WS_END = 510 * MiB;
#ifndef DUP
#define DUP 0
#endif
#define REP(bit) for (int rep_ = 0; rep_ < (((DUP) >> (bit)) & 1) + 1; ++rep_)

struct Params {
    const float* in[32];
    float* out;
    unsigned char* ws;
};

__device__ __forceinline__ float bf2f(unsigned short b) { return __uint_as_float(((unsigned)b) << 16); }
__device__ __forceinline__ unsigned short f2bf(float f) { unsigned u = __float_as_uint(f); u += 0x7FFFu + ((u >> 16) & 1u); return (unsigned short)(u >> 16); }
__device__ __forceinline__ unsigned cvt_pk_bf16(float lo, float hi) { unsigned r; asm volatile("v_cvt_pk_bf16_f32 %0, %1, %2" : "=v"(r) : "v"(lo), "v"(hi)); return r; }
__device__ __forceinline__ float bflo(unsigned w) { return __uint_as_float(w << 16); }
__device__ __forceinline__ float bfhi(unsigned w) { return __uint_as_float(w & 0xffff0000u); }
__device__ __forceinline__ float sigmoidf_(float x) { return 1.0f / (1.0f + __expf(-x)); }
__device__ __forceinline__ float siluf_(float x) { return x * sigmoidf_(x); }
__device__ __forceinline__ float tanhf_(float x) { const float e = __expf(2.0f * x); return 1.0f - 2.0f / (e + 1.0f); }
__device__ __forceinline__ float gelu_tanh(float y) { const float u = 0.7978845608028654f * (y + 0.044715f * y * y * y); return 0.5f * y * (1.0f + tanhf_(u)); }
__device__ __forceinline__ float wave_sum(float v) {
#pragma unroll
    for (int o = 32; o >= 1; o >>= 1) v += __shfl_xor(v, o);
    return v;
}
template <int CTRL> __device__ __forceinline__ float dpp_f(float x) { return __builtin_bit_cast(float, __builtin_amdgcn_update_dpp(0, __builtin_bit_cast(int, x), CTRL, 0xF, 0xF, false)); }
__device__ __forceinline__ float red16(float x) { x += dpp_f<0x128>(x); x += dpp_f<0x124>(x); x += dpp_f<0x122>(x); x += dpp_f<0x121>(x); return x; }

__device__ __forceinline__ float red8(float x) { x += dpp_f<0xB1>(x); x += dpp_f<0x4E>(x); x += dpp_f<0x141>(x); return x; }
__device__ __forceinline__ void unpack8(u32x4 v, float (&o)[8]) { o[0] = bflo(v.x); o[1] = bfhi(v.x); o[2] = bflo(v.y); o[3] = bfhi(v.y); o[4] = bflo(v.z); o[5] = bfhi(v.z); o[6] = bflo(v.w); o[7] = bfhi(v.w); }
__device__ __forceinline__ u32x4 pack8a(const float (&v)[8]) { u32x4 w; w.x = cvt_pk_bf16(v[0], v[1]); w.y = cvt_pk_bf16(v[2], v[3]); w.z = cvt_pk_bf16(v[4], v[5]); w.w = cvt_pk_bf16(v[6], v[7]); return w; }
template <class T> __device__ __forceinline__ T ldnt(const T* p) { return __builtin_nontemporal_load(p); }
template <class T> __device__ __forceinline__ void stnt(T* p, T v) { __builtin_nontemporal_store(v, p); }
__device__ __forceinline__ int otid() { int t = threadIdx.x; asm volatile("" : "+v"(t)); return t; }
namespace pg8 {
constexpr int BM = 256, BK = 64, HALF = 128, HTB = HALF * BK * 2, STAGE_BYTES = 8 * HTB, NXCD = 8, WGM = 8;
__host__ __device__ __forceinline__ int lds_byte(int r, int c) { const int st = (r >> 4) * 2 + (c >> 5), rr = r & 15, cc = c & 31, ob = rr * 64 + cc * 2; return st * 1024 + (ob ^ (((ob >> 9) & 1) << 5)); }
__host__ __device__ __forceinline__ void stage_rc(int b, int& R, int& C) { const int st = b / 1024, sb = b % 1024, swz = sb ^ (((sb >> 9) & 1) << 5); R = (st >> 1) * 16 + swz / 64; C = (st & 1) * 32 + (swz % 64) / 2; }
__host__ __device__ __forceinline__ int perm32(int rho) { const int n = rho >> 4, i = rho & 15; return 8 * (i >> 2) + 4 * n + (i & 3); }

struct Unit { int pm, pn; };
struct Gemm { const bf16_t* A; const bf16_t* Bt; int M, N, K, lda, ldb, gm; size_t gstrideB; };

struct StaticOrder {
    int nM, nN, nwg, G, c;
    __host__ __device__ void init(int M, int N, int G_, int c_) { nM = M / BM; nN = N / BM; nwg = nM * nN; G = G_; c = c_; }
    __host__ __device__ bool next(int i, Unit& u) const {
        const long L = (long)i * G + c; if (L >= nwg) return false;
        int wgid = (int)L; { const int q = nwg / NXCD, r = nwg % NXCD, xcd = wgid % NXCD, off = wgid / NXCD; wgid = (xcd < r ? xcd * (q + 1) : r * (q + 1) + (xcd - r) * q) + off; }
        const int nig = WGM * nN, gid = wgid / nig, fm = gid * WGM, gsz = (nM - fm) < WGM ? (nM - fm) : WGM;
        u.pm = fm + ((wgid % nig) % gsz); u.pn = (wgid % nig) / gsz; return true;
    }
};

template <class Epi, class Sched>
__device__ __forceinline__ void gemm_phase(LAS unsigned char* lds, const Gemm g, const Sched& S, const Epi& E) {
    int tid_ = otid(); asm volatile("" : "+v"(tid_));
    const int tid = tid_, wid = __builtin_amdgcn_readfirstlane(tid >> 6), lane = tid & 63, wr = wid >> 2, wc = wid & 3, fr = lane & 15, fq = lane >> 4;
    const int K = g.K, nt = K / BK;
    unsigned voffA, voffB;
    { int R, C; stage_rc(tid * 16, R, C); const int Rb = Epi::PERM ? ((R & ~31) + perm32(R & 31)) : R;
        voffA = (unsigned)(R * g.lda + C) * 2u; voffB = (unsigned)(Rb * g.ldb + C) * 2u; }
    const size_t dA = (size_t)64 * g.lda * 2, dB = (size_t)64 * g.ldb * 2;
    const size_t kstep = (size_t)(BK * 2);
    const size_t hstepA = (size_t)HALF * g.lda * 2, hstepB = (size_t)HALF * g.ldb * 2;
    const size_t tstepA = 2 * hstepA, tstepB = 2 * hstepB;
    const unsigned ldsw = (unsigned)wid * 1024u;
    const int aoff = lds_byte(wr * 64 + fr, fq * 8), boff = lds_byte(wc * 32 + fr, fq * 8);
#define PG8_SA(b, h) (((b) * 2 + (h)) * HTB)
#define PG8_SB(b, h) ((4 + (b) * 2 + (h)) * HTB)
#define PG8_STAGE(bufoff, gbase, voff) do { _Pragma("unroll") for (int _i = 0; _i < 2; ++_i) \
        __builtin_amdgcn_global_load_lds((const unsigned*)((const char*)(gbase) + (size_t)_i * PG8_D_##voff + (voff)), (LAS unsigned*)(lds + (bufoff) + ldsw + _i * 8192), 16, 0, 0); } while (0)
#define PG8_D_voffA dA
#define PG8_D_voffB dB
#define PG8_LDA(dst, b, h) do { _Pragma("unroll") for (int m = 0; m < 4; ++m) _Pragma("unroll") for (int k = 0; k < 2; ++k) dst[m][k] = *(const LAS bf16x8*)(lds + PG8_SA(b, h) + aoff + m * 2048 + k * 1024); } while (0)
#define PG8_LDB(dst, b, h) do { _Pragma("unroll") for (int n = 0; n < 2; ++n) _Pragma("unroll") for (int k = 0; k < 2; ++k) dst[n][k] = *(const LAS bf16x8*)(lds + PG8_SB(b, h) + boff + n * 2048 + k * 1024); } while (0)
#define PG8_MMA(ai, bj, At, Bt) do { __builtin_amdgcn_s_setprio(1); _Pragma("unroll") for (int m = 0; m < 4; ++m) _Pragma("unroll") for (int n = 0; n < 2; ++n) _Pragma("unroll") for (int k = 0; k < 2; ++k) \
        acc[ai][bj][m][n] = __builtin_amdgcn_mfma_f32_16x16x32_bf16(Bt[n][k], At[m][k], acc[ai][bj][m][n], 0, 0, 0); __builtin_amdgcn_s_setprio(0); } while (0)
#define PG8_WAIT_V(n) asm volatile("s_waitcnt vmcnt(" #n ")" ::: "memory")
#define PG8_WAIT_L(n) asm volatile("s_waitcnt lgkmcnt(" #n ")" ::: "memory")
#define PG8_BAR __builtin_amdgcn_s_barrier()
#define PG8_SCHED __builtin_amdgcn_sched_barrier(0)
    Unit cur, nxt; int ui = 0;
    if (!S.next(0, cur)) return;
    cur.pm = __builtin_amdgcn_readfirstlane(cur.pm); cur.pn = __builtin_amdgcn_readfirstlane(cur.pn);
    f32x4 acc[2][2][4][2];
#pragma unroll
    for (int a = 0; a < 2; ++a)
#pragma unroll
        for (int b = 0; b < 2; ++b)
#pragma unroll
            for (int m = 0; m < 4; ++m)
#pragma unroll
                for (int n = 0; n < 2; ++n) acc[a][b][m][n] = (f32x4){0.f, 0.f, 0.f, 0.f};
    bf16x8 At[4][2], B0[2][2], B1[2][2];
    const char* cA = (const char*)g.A + (size_t)cur.pm * tstepA;
    const char* cB = (const char*)g.Bt + (size_t)(cur.pm >> g.gm) * g.gstrideB + (size_t)cur.pn * tstepB;
    PG8_STAGE(PG8_SB(0, 0), cB, voffB); PG8_STAGE(PG8_SA(0, 0), cA, voffA); PG8_STAGE(PG8_SB(0, 1), cB + hstepB, voffB); PG8_STAGE(PG8_SA(0, 1), cA + hstepA, voffA);
    if (wr == 1) PG8_BAR;
    PG8_WAIT_V(4); PG8_BAR;
    PG8_STAGE(PG8_SB(1, 0), cB + kstep, voffB); PG8_STAGE(PG8_SA(1, 0), cA + kstep, voffA); PG8_STAGE(PG8_SB(1, 1), cB + hstepB + kstep, voffB);
    PG8_WAIT_V(6); PG8_BAR;
    for (;;) {
        const bool has_next = S.next(ui + 1, nxt);
        nxt.pm = __builtin_amdgcn_readfirstlane(nxt.pm); nxt.pn = __builtin_amdgcn_readfirstlane(nxt.pn);
        const char* nA = has_next ? (const char*)g.A + (size_t)nxt.pm * tstepA : cA;
        const char* nB = has_next ? (const char*)g.Bt + (size_t)(nxt.pm >> g.gm) * g.gstrideB + (size_t)nxt.pn * tstepB : cB;
        for (int t = 0; t < nt; t += 2) {
            const bool last = (t == nt - 2);
            const char* a1 = cA + (size_t)(t + 1) * kstep;
            const char* a2 = last ? nA : cA + (size_t)(t + 2) * kstep; const char* b2 = last ? nB : cB + (size_t)(t + 2) * kstep;
            const char* a3 = a2 + kstep; const char* b3 = b2 + kstep;
            PG8_LDB(B0, 0, 0); PG8_SCHED; PG8_LDA(At, 0, 0); PG8_STAGE(PG8_SA(1, 1), a1 + hstepA, voffA);
            PG8_WAIT_L(8); PG8_BAR; PG8_WAIT_L(0); PG8_MMA(0, 0, At, B0); PG8_BAR; PG8_SCHED;
            PG8_LDB(B1, 0, 1); PG8_STAGE(PG8_SB(0, 0), b2, voffB);
            PG8_BAR; PG8_WAIT_L(0); PG8_MMA(0, 1, At, B1); PG8_BAR;
            PG8_LDA(At, 0, 1); PG8_STAGE(PG8_SA(0, 0), a2, voffA);
            PG8_BAR; PG8_WAIT_L(0); PG8_MMA(1, 0, At, B0); PG8_BAR; PG8_SCHED;
            PG8_STAGE(PG8_SB(0, 1), b2 + hstepB, voffB);
            PG8_WAIT_V(6); PG8_BAR; PG8_MMA(1, 1, At, B1); PG8_BAR;
            PG8_LDB(B0, 1, 0); PG8_SCHED; PG8_LDA(At, 1, 0); PG8_STAGE(PG8_SA(0, 1), a2 + hstepA, voffA);
            PG8_WAIT_L(8); PG8_BAR; PG8_WAIT_L(0); PG8_MMA(0, 0, At, B0); PG8_BAR; PG8_SCHED;
            PG8_LDB(B1, 1, 1); PG8_STAGE(PG8_SB(1, 0), b3, voffB);
            PG8_BAR; PG8_WAIT_L(0); PG8_MMA(0, 1, At, B1); PG8_BAR;
            PG8_LDA(At, 1, 1); PG8_STAGE(PG8_SA(1, 0), a3, voffA);
            PG8_BAR; PG8_WAIT_L(0); PG8_MMA(1, 0, At, B0); PG8_BAR; PG8_SCHED;
            PG8_STAGE(PG8_SB(1, 1), b3 + hstepB, voffB);
            PG8_WAIT_V(6); PG8_BAR; PG8_MMA(1, 1, At, B1); PG8_BAR;
        }
        { const int l2 = otid() & 63; E(acc, cur, wr, wc, l2 & 15, l2 >> 4); }
        if (!has_next) break;
#pragma unroll
        for (int a = 0; a < 2; ++a)
#pragma unroll
            for (int b = 0; b < 2; ++b)
#pragma unroll
                for (int m = 0; m < 4; ++m)
#pragma unroll
                    for (int n = 0; n < 2; ++n) acc[a][b][m][n] = (f32x4){0.f, 0.f, 0.f, 0.f};
        cur = nxt; cA = nA; cB = nB; ++ui;
    }
    PG8_WAIT_V(0);
    if (wr == 0) PG8_BAR;
    PG8_BAR;
#undef PG8_SA
#undef PG8_SB
#undef PG8_STAGE
#undef PG8_D_voffA
#undef PG8_D_voffB
#undef PG8_LDA
#undef PG8_LDB
#undef PG8_MMA
#undef PG8_WAIT_V
#undef PG8_WAIT_L
#undef PG8_BAR
#undef PG8_SCHED
}
}
using pg8::Unit;

#define EPI_ROW(ai, m) (u.pm * 256 + (ai) * 128 + wr * 64 + (m) * 16 + fr)
typedef const f32x4 (&AccRef)[2][2][4][2];
__device__ __forceinline__ u32x4 pack8(f32x4 v0, f32x4 v1) { u32x4 w; w.x = cvt_pk_bf16(v0[0], v0[1]); w.y = cvt_pk_bf16(v0[2], v0[3]); w.z = cvt_pk_bf16(v1[0], v1[1]); w.w = cvt_pk_bf16(v1[2], v1[3]); return w; }

struct EpiIn {
    static constexpr bool PERM = true;
    bf16_t *R; const float* rstd1; const float* bias1;
    __device__ __forceinline__ void operator()(AccRef acc, const Unit& u, int wr, int wc, int fr, int fq) const {
        const int pn = u.pn, b = (u.pm * 256) >> 13;
        f32x4 bv[2][2];
#pragma unroll
        for (int bj = 0; bj < 2; ++bj)
#pragma unroll
            for (int n = 0; n < 2; ++n) bv[bj][n] = *(const f32x4*)(bias1 + b * DIN + pn * 256 + bj * 128 + wc * 32 + 8 * fq + 4 * n);
#pragma unroll
        for (int ai = 0; ai < 2; ++ai)
#pragma unroll
            for (int m = 0; m < 4; ++m) {
                const int row = EPI_ROW(ai, m); const float rs = rstd1[row];
#pragma unroll
                for (int bj = 0; bj < 2; ++bj) {
                    const u32x4 w = pack8(acc[ai][bj][m][0] * rs + bv[bj][0], acc[ai][bj][m][1] * rs + bv[bj][1]);
                    const int cl = bj * 128 + wc * 32 + 8 * fq;
                    size_t eo;
                    if (pn < 6) eo = (size_t)(pn >> 1) * (16u << 20) + (size_t)row * 512 + (pn & 1) * 256 + cl;
                    else if (pn == 6) eo = (WS_LO - WS_R) / 2 + (size_t)row * 256 + cl;
                    else { const int cu = (pn - 7) * 256 + cl, g = cu >> 4, ch = cu & 15; eo = (WS_USIN - WS_R) / 2 + ((size_t)(g * 2048 + (row >> 4)) * 384 + (row & 15) * 16 + ch); }
                    *(u32x4*)(R + eo) = w;
                }
            }
    }
};
struct EpiLora {
    static constexpr bool PERM = true;
    bf16_t* W; bf16_t* AA; bf16_t* G; const float* w0; const float* a0; int pn_off;
    static __device__ __forceinline__ float decay_of(float x) { return 0.6065306597126334f * sigmoidf_(x); }
    __device__ __forceinline__ void operator()(AccRef acc, const Unit& u, int wr, int wc, int fr, int fq) const {
        const int pnx = u.pn + pn_off, type = pnx >> 1, cb = (pnx & 1) * 256 + wc * 32 + 8 * fq;
        if (type == 0) {
#pragma unroll
            for (int bj = 0; bj < 2; ++bj) {
                const int c8 = cb + bj * 128; const f32x4 b0 = *(const f32x4*)(w0 + c8), b1 = *(const f32x4*)(w0 + c8 + 4);
#pragma unroll
                for (int ai = 0; ai < 2; ++ai)
#pragma unroll
                    for (int m = 0; m < 4; ++m) {
                        const int row = EPI_ROW(ai, m); f32x4 v0 = acc[ai][bj][m][0] + b0, v1 = acc[ai][bj][m][1] + b1;
#pragma unroll
                        for (int j = 0; j < 4; ++j) { v0[j] = decay_of(v0[j]); v1[j] = decay_of(v1[j]); }
                        *(u32x4*)(W + (size_t)row * 512 + c8) = pack8(v0, v1);
                    }
            }
        } else if (type == 1) {
#pragma unroll
            for (int bj = 0; bj < 2; ++bj) {
                const int c8 = cb + bj * 128; const f32x4 b0 = *(const f32x4*)(a0 + c8), b1 = *(const f32x4*)(a0 + c8 + 4);
#pragma unroll
                for (int ai = 0; ai < 2; ++ai)
#pragma unroll
                    for (int m = 0; m < 4; ++m) {
                        const int row = EPI_ROW(ai, m); f32x4 v0 = acc[ai][bj][m][0] + b0, v1 = acc[ai][bj][m][1] + b1;
#pragma unroll
                        for (int j = 0; j < 4; ++j) { v0[j] = sigmoidf_(v0[j]); v1[j] = sigmoidf_(v1[j]); }
                        *(u32x4*)(AA + (size_t)row * 512 + c8) = pack8(v0, v1);
                    }
            }
        } else {
#pragma unroll
            for (int bj = 0; bj < 2; ++bj)
#pragma unroll
                for (int ai = 0; ai < 2; ++ai)
#pragma unroll
                    for (int m = 0; m < 4; ++m) {
                        const int row = EPI_ROW(ai, m);
                        *(u32x4*)(G + (size_t)row * 512 + cb + bj * 128) = pack8(acc[ai][bj][m][0], acc[ai][bj][m][1]);
                    }
        }
    }
};
struct EpiS1 {
    static constexpr bool PERM = true;
    bf16_t* SLOC;
    __device__ __forceinline__ void operator()(AccRef acc, const Unit& u, int wr, int wc, int fr, int fq) const {
#pragma unroll
        for (int ai = 0; ai < 2; ++ai)
#pragma unroll
            for (int m = 0; m < 4; ++m) {
                const int row = EPI_ROW(ai, m);
                *(u32x4*)(SLOC + (size_t)row * 128 + wc * 32 + 8 * fq) = pack8(acc[ai][0][m][0], acc[ai][0][m][1]);
            }
    }
};
struct EpiS2 {
    static constexpr bool PERM = true;
    const bf16_t* USIN; bf16_t* ZZ; const float* dskip;
    __device__ __forceinline__ void operator()(AccRef acc, const Unit& u, int wr, int wc, int fr, int fq) const {
#pragma unroll
        for (int ai = 0; ai < 2; ++ai)
#pragma unroll
            for (int m = 0; m < 4; ++m) {
                const int row = EPI_ROW(ai, m), g = row >> 11, rig = row & 2047;
#pragma unroll
                for (int bj = 0; bj < 2; ++bj) {
                    const int col = bj * 128 + wc * 32 + 8 * fq, t = col >> 4, c = col & 15;
                    const u32x4 uu = *(const u32x4*)(USIN + (size_t)row * 384 + col);
                    const f32x4 d0 = *(const f32x4*)(dskip + g * 16 + c), d1 = *(const f32x4*)(dskip + g * 16 + c + 4);
                    f32x4 v0 = acc[ai][bj][m][0], v1 = acc[ai][bj][m][1];
                    v0[0] += d0[0] * bflo(uu.x); v0[1] += d0[1] * bfhi(uu.x); v0[2] += d0[2] * bflo(uu.y); v0[3] += d0[3] * bfhi(uu.y);
                    v1[0] += d1[0] * bflo(uu.z); v1[1] += d1[1] * bfhi(uu.z); v1[2] += d1[2] * bflo(uu.w); v1[3] += d1[3] * bfhi(uu.w);
#pragma unroll
                    for (int j = 0; j < 4; ++j) { v0[j] = gelu_tanh(v0[j]); v1[j] = gelu_tanh(v1[j]); }
                    *(u32x4*)(ZZ + (size_t)(rig * 16 + t) * 512 + g * 16 + c) = pack8(v0, v1);
                }
            }
    }
};
struct EpiGlu {
    static constexpr bool PERM = true;
    const bf16_t* ZZ; bf16_t* GLUO; const float* bglu; float* rss;
    __device__ __forceinline__ void operator()(AccRef acc, const Unit& u, int wr, int wc, int fr, int fq) const {
#pragma unroll
        for (int ai = 0; ai < 2; ++ai)
#pragma unroll
            for (int m = 0; m < 4; ++m) {
                const int row = EPI_ROW(ai, m); float ss = 0.f;
#pragma unroll
                for (int bj = 0; bj < 2; ++bj) {
                    const int col = u.pn * 256 + bj * 128 + wc * 32 + 8 * fq;
                    const u32x4 zz = *(const u32x4*)(ZZ + (size_t)row * 512 + col);
                    const f32x4 b0 = *(const f32x4*)(bglu + col), b1 = *(const f32x4*)(bglu + col + 4);
                    f32x4 v0 = acc[ai][bj][m][0] + b0, v1 = acc[ai][bj][m][1] + b1;
                    v0[0] = bflo(zz.x) * sigmoidf_(v0[0]); v0[1] = bfhi(zz.x) * sigmoidf_(v0[1]); v0[2] = bflo(zz.y) * sigmoidf_(v0[2]); v0[3] = bfhi(zz.y) * sigmoidf_(v0[3]);
                    v1[0] = bflo(zz.z) * sigmoidf_(v1[0]); v1[1] = bfhi(zz.z) * sigmoidf_(v1[1]); v1[2] = bflo(zz.w) * sigmoidf_(v1[2]); v1[3] = bfhi(zz.w) * sigmoidf_(v1[3]);
#pragma unroll
                    for (int j = 0; j < 4; ++j) ss += v0[j] * v0[j] + v1[j] * v1[j];
                    *(u32x4*)(GLUO + (size_t)row * 512 + col) = pack8(v0, v1);
                }
                ss += __shfl_xor(ss, 16); ss += __shfl_xor(ss, 32);
                if (fq == 0) rss[(size_t)row * 8 + u.pn * 4 + wc] = ss;
            }
    }
};
struct EpiOut {
    static constexpr bool PERM = true;
    const float* x; bf16_t* X1; bf16_t* A2; const float* ada; float* rss;
    __device__ __forceinline__ void operator()(AccRef acc, const Unit& u, int wr, int wc, int fr, int fq) const {
        const int b = (u.pm * 256) >> 13;
        const float* gm = ada + b * 6144 + 2048; const float* scf = ada + b * 6144 + 4096;
        f32x4 gv[2][2], sv[2][2];
#pragma unroll
        for (int bj = 0; bj < 2; ++bj)
#pragma unroll
            for (int n = 0; n < 2; ++n) { const int col = u.pn * 256 + bj * 128 + wc * 32 + 8 * fq + 4 * n; gv[bj][n] = *(const f32x4*)(gm + col); sv[bj][n] = *(const f32x4*)(scf + col) + 1.0f; }
#pragma unroll
        for (int ai = 0; ai < 2; ++ai)
#pragma unroll
            for (int m = 0; m < 4; ++m) {
                const int row = EPI_ROW(ai, m); float ss = 0.f;
#pragma unroll
                for (int bj = 0; bj < 2; ++bj) {
                    const size_t off = (size_t)row * 1024 + u.pn * 256 + bj * 128 + wc * 32 + 8 * fq;
                    const f32x4 x0 = ldnt((const f32x4*)(x + off)) + gv[bj][0] * acc[ai][bj][m][0];
                    const f32x4 x1 = ldnt((const f32x4*)(x + off + 4)) + gv[bj][1] * acc[ai][bj][m][1];
                    *(u32x4*)(X1 + off) = pack8(x0, x1);
                    ss += (x0[0] * x0[0] + x0[1] * x0[1] + x0[2] * x0[2] + x0[3] * x0[3]) + (x1[0] * x1[0] + x1[1] * x1[1] + x1[2] * x1[2] + x1[3] * x1[3]);
                    *(u32x4*)(A2 + off) = pack8(x0 * sv[bj][0], x1 * sv[bj][1]);
                }
                ss += __shfl_xor(ss, 16); ss += __shfl_xor(ss, 32);
                if (fq == 0) rss[(size_t)row * 16 + u.pn * 4 + wc] = ss;
            }
    }
};
struct EpiGU {
    static constexpr bool PERM = true;
    bf16_t* HMID; const float* rss2; const float* bias2;
    __device__ __forceinline__ void operator()(AccRef acc, const Unit& u, int wr, int wc, int fr, int fq) const {
        const int b = (u.pm * 256) >> 13;
        f32x4 bv[2][2];
#pragma unroll
        for (int bj = 0; bj < 2; ++bj)
#pragma unroll
            for (int n = 0; n < 2; ++n) bv[bj][n] = *(const f32x4*)(bias2 + b * 5632 + u.pn * 256 + bj * 128 + wc * 32 + 8 * fq + 4 * n);
#pragma unroll
        for (int ai = 0; ai < 2; ++ai)
#pragma unroll
            for (int m = 0; m < 4; ++m) {
                const int row = EPI_ROW(ai, m); const f32x4* rp = (const f32x4*)(rss2 + (size_t)row * 16); const f32x4 q4 = (rp[0] + rp[1]) + (rp[2] + rp[3]); const float rs = rsqrtf(((q4[0] + q4[1]) + (q4[2] + q4[3])) * (1.0f / 1024.0f) + 1e-6f);
                f32x4 h0, h1;
#pragma unroll
                for (int j = 0; j < 4; ++j) {
                    const float g0 = acc[ai][0][m][0][j] * rs + bv[0][0][j], u0 = acc[ai][1][m][0][j] * rs + bv[1][0][j];
                    const float g1 = acc[ai][0][m][1][j] * rs + bv[0][1][j], u1 = acc[ai][1][m][1][j] * rs + bv[1][1][j];
                    h0[j] = siluf_(g0) * u0; h1[j] = siluf_(g1) * u1;
                }
                *(u32x4*)(HMID + (size_t)row * DFF + u.pn * 128 + wc * 32 + 8 * fq) = pack8(h0, h1);
            }
    }
};
struct EpiDown {
    static constexpr bool PERM = true;
    const bf16_t* X1; bf16_t* out; const float* ada; float* rss;
    __device__ __forceinline__ void operator()(AccRef acc, const Unit& u, int wr, int wc, int fr, int fq) const {
        const int b = (u.pm * 256) >> 13;
        const float* gf = ada + b * 6144 + 5120;
        f32x4 gv[2][2];
#pragma unroll
        for (int bj = 0; bj < 2; ++bj)
#pragma unroll
            for (int n = 0; n < 2; ++n) gv[bj][n] = *(const f32x4*)(gf + u.pn * 256 + bj * 128 + wc * 32 + 8 * fq + 4 * n);
#pragma unroll
        for (int ai = 0; ai < 2; ++ai)
#pragma unroll
            for (int m = 0; m < 4; ++m) {
                const int row = EPI_ROW(ai, m); float ss = 0.f;
#pragma unroll
                for (int bj = 0; bj < 2; ++bj) {
                    const size_t off = (size_t)row * 1024 + u.pn * 256 + bj * 128 + wc * 32 + 8 * fq;
                    const u32x4 xb = ldnt((const u32x4*)(X1 + off));
                    const f32x4 x0 = (f32x4){bflo(xb.x), bfhi(xb.x), bflo(xb.y), bfhi(xb.y)} + gv[bj][0] * acc[ai][bj][m][0];
                    const f32x4 x1 = (f32x4){bflo(xb.z), bfhi(xb.z), bflo(xb.w), bfhi(xb.w)} + gv[bj][1] * acc[ai][bj][m][1];
                    *(u32x4*)(out + off) = pack8(x0, x1);
                    ss += (x0[0] * x0[0] + x0[1] * x0[1] + x0[2] * x0[2] + x0[3] * x0[3]) + (x1[0] * x1[0] + x1[1] * x1[1] + x1[2] * x1[2] + x1[3] * x1[3]);
                }
                ss += __shfl_xor(ss, 16); ss += __shfl_xor(ss, 32);
                if (fq == 0) rss[(size_t)row * 16 + u.pn * 4 + wc] = ss;
            }
    }
};

enum { I_X = 0, I_C, I_WADA, I_BADA, I_WIN, I_MU, I_W0, I_W2, I_A0, I_A2, I_G2, I_KK, I_KA, I_RK, I_LNW, I_LNB, I_SARE, I_SAIM, I_SLDT,
       I_SBRE, I_SBIM, I_SCRE, I_SCIM, I_SD, I_WGLU, I_BGLU, I_SGAIN, I_WOUT, I_FG, I_FU, I_FD, I_FGAIN };

template <class Map>
__device__ __forceinline__ void transpose_cvt(bf16_t* dst, const float* src, int Nd, int Kd, int ld, Map map, int gtid, int gthreads) {
    const int items = Nd * (Kd / 8);
    for (int it0 = gtid; it0 < items; it0 += 2 * gthreads) {
        float v[2][8];
#pragma unroll
        for (int u = 0; u < 2; ++u) { const int it = it0 + u * gthreads; if (it < items) { const int n = it % Nd, k8 = it / Nd; const int sc = map(n);
#pragma unroll
            for (int j = 0; j < 8; ++j) v[u][j] = src[(size_t)(k8 * 8 + j) * ld + sc]; } }
#pragma unroll
        for (int u = 0; u < 2; ++u) { const int it = it0 + u * gthreads; if (it < items) { const int n = it % Nd, k8 = it / Nd;
            u32x4 w; w.x = cvt_pk_bf16(v[u][0], v[u][1]); w.y = cvt_pk_bf16(v[u][2], v[u][3]); w.z = cvt_pk_bf16(v[u][4], v[u][5]); w.w = cvt_pk_bf16(v[u][6], v[u][7]);
            *(u32x4*)(dst + (size_t)n * Kd + k8 * 8) = w; } }
    }
}

__device__ __forceinline__ void s5_mats(const Params& p, int g, int part, LAS unsigned char* lds) {
    LAS float* ap_re = (LAS float*)lds;
    LAS float* ap_im = ap_re + 17 * 64;
    LAS float* bb_re = ap_im + 17 * 64;
    LAS float* bb_im = bb_re + 1024;
    LAS float* c_re = bb_im + 1024;
    LAS float* c_im = c_re + 1024;
    LAS float* ktab = c_im + 1024;
    const int tid = otid();
    const float dt = expf(p.in[I_SLDT][g]);
    const float* are_p = p.in[I_SARE] + g * 64; const float* aim_p = p.in[I_SAIM] + g * 64;
    for (int i = tid; i < 17 * 64; i += 512) { const int tau = i >> 6, pp = i & 63; const float mag = expf((float)tau * dt * are_p[pp]), ang = (float)tau * dt * aim_p[pp]; ap_re[i] = mag * cosf(ang); ap_im[i] = mag * sinf(ang); }
    for (int i = tid; i < 1024; i += 512) {
        const int pp = i >> 4;
        const float are = are_p[pp], aim = aim_p[pp], mag = expf(dt * are), abr = mag * cosf(dt * aim), abi = mag * sinf(dt * aim), den = are * are + aim * aim;
        const float pr = abr - 1.0f, q = abi, cre = (pr * are + q * aim) / den, cim = (q * are - pr * aim) / den;
        const float bre = p.in[I_SBRE][(size_t)g * 1024 + i], bim = p.in[I_SBIM][(size_t)g * 1024 + i];
        bb_re[i] = cre * bre - cim * bim; bb_im[i] = cre * bim + cim * bre;
        c_re[i] = p.in[I_SCRE][(size_t)g * 1024 + i]; c_im[i] = p.in[I_SCIM][(size_t)g * 1024 + i];
    }
    __syncthreads();
    {   const int i = tid, tau = i >> 5, cl = (i >> 4) & 1, cc = 2 * part + cl, c2 = i & 15; float s = 0.f;
        for (int pp = 0; pp < 64; ++pp) {
            const float cr = c_re[cc * 64 + pp], ci = c_im[cc * 64 + pp], ar = ap_re[tau * 64 + pp], ai = ap_im[tau * 64 + pp];
            const float xr = cr * ar - ci * ai, xi = cr * ai + ci * ar;
            s += xr * bb_re[pp * 16 + c2] - xi * bb_im[pp * 16 + c2];
        }
        ktab[i] = s; }
    __syncthreads();
    bf16_t* TV = (bf16_t*)(p.ws + WS_S5TV) + (size_t)g * 256 * 384;
    for (int i = tid; i < 32 * 384; i += 512) {
        const int rr = i / 384, kk = i % 384, t = rr >> 1, cl = rr & 1, cc = 2 * part + cl, n = t * 16 + cc; float val;
        if (kk < 256) { const int sx = kk >> 4, c2 = kk & 15; val = (sx <= t) ? ktab[(t - sx) * 32 + cl * 16 + c2] : 0.f; }
        else { const int q = kk - 256, pp = q & 63, tau = t + 1; const float cr = c_re[cc * 64 + pp], ci = c_im[cc * 64 + pp], ar = ap_re[tau * 64 + pp], ai = ap_im[tau * 64 + pp];
            val = (q < 64) ? (cr * ar - ci * ai) : -(cr * ai + ci * ar); }
        TV[(size_t)n * 384 + kk] = f2bf(val);
    }
    bf16_t* WG = (bf16_t*)(p.ws + WS_S5W) + (size_t)g * 256 * 256;
    for (int i = tid; i < 32 * 256; i += 512) {
        const int rr = i >> 8, kk = i & 255, sx = kk >> 4, c2 = kk & 15, n = (rr < 16) ? (16 * part + rr) : (128 + 16 * part + (rr - 16)); float val = 0.f;
        if (n < 128) { const int pp = n & 63, tau = 15 - sx; const float ar = ap_re[tau * 64 + pp], ai = ap_im[tau * 64 + pp], br = bb_re[pp * 16 + c2], bi = bb_im[pp * 16 + c2];
            val = (n < 64) ? (ar * br - ai * bi) : (ar * bi + ai * br); }
        WG[(size_t)n * 256 + kk] = f2bf(val);
    }
    __syncthreads();
}

__device__ __forceinline__ void phase0(const Params& p, LAS unsigned char* lds, bool do_ada) {
    const int tid = otid(), nblk = gridDim.x, blk = blockIdx.x;
    unsigned char* ws = p.ws;
    float* ada = (float*)(ws + WS_SMALL + SM_ADA);
    const int nada = (nblk >= 192) ? 96 : (nblk > 1 ? nblk / 2 : 1);
    if (blk < nada) {
        if (do_ada) {
            const int lane = tid & 63, wv = tid >> 6; LAS float* part = (LAS float*)lds;
            LAS float* sil = part + 2048;
            for (int i = tid; i < 4096; i += 512) sil[i] = siluf_(p.in[I_C][i]);
            __syncthreads();
            for (int cbk = blk; cbk < 96; cbk += nada) {
                const int col = cbk * 64 + lane; float a0 = 0.f, a1 = 0.f, a2 = 0.f, a3 = 0.f;
                const float* wp = p.in[I_WADA] + (size_t)(wv * 128) * 6144 + col; const LAS float* sp = sil + wv * 128;
                for (int k0 = 0; k0 < 128; k0 += 16) {
                    float w[16];
#pragma unroll
                    for (int j = 0; j < 16; ++j) w[j] = wp[(size_t)(k0 + j) * 6144];
#pragma unroll
                    for (int j = 0; j < 16; ++j) { a0 += sp[k0 + j] * w[j]; a1 += sp[1024 + k0 + j] * w[j]; a2 += sp[2048 + k0 + j] * w[j]; a3 += sp[3072 + k0 + j] * w[j]; }
                }
                __syncthreads();
                part[(wv * 4 + 0) * 64 + lane] = a0; part[(wv * 4 + 1) * 64 + lane] = a1; part[(wv * 4 + 2) * 64 + lane] = a2; part[(wv * 4 + 3) * 64 + lane] = a3;
                __syncthreads();
                if (tid < 256) { const int bb = tid >> 6; float sacc = p.in[I_BADA][col];
#pragma unroll
                    for (int w8 = 0; w8 < 8; ++w8) sacc += part[(w8 * 4 + bb) * 64 + lane];
                    ada[bb * 6144 + col] = sacc; }
            }
            __syncthreads();
        }
        if (nblk > nada) return;
    }
    const int tb_ = (nblk > nada) ? blk - nada : blk, tn_ = (nblk > nada) ? nblk - nada : nblk;
    const int gtid = tb_ * 512 + tid, gth = tn_ * 512;
    transpose_cvt((bf16_t*)(ws + WS_WIN_T), p.in[I_WIN], 2304, 1024, 2304, [](int n) { return n; }, gtid, gth);
}

__device__ __forceinline__ void late_weights(const Params& p, int gtid, int gth) {
    unsigned char* ws = p.ws;
    transpose_cvt((bf16_t*)(ws + WS_WOUT_T), p.in[I_WOUT], 1024, 1024, 1024, [](int n) { return n; }, gtid, gth);
    transpose_cvt((bf16_t*)(ws + WS_DOWN_T), p.in[I_FD], 1024, 2816, 1024, [](int n) { return n; }, gtid, gth);
    {
        bf16_t* dst = (bf16_t*)(ws + WS_GU_T);
        const int items = 5632 * 128;
        for (int it0 = gtid; it0 < items; it0 += 2 * gth) {
            float v[2][8];
#pragma unroll
            for (int u = 0; u < 2; ++u) { const int it = it0 + u * gth; if (it < items) { const int n = it % 5632, k8 = it / 5632, pn = n >> 8, wi = n & 255; const float* src = (wi < 128) ? p.in[I_FG] : p.in[I_FU]; const int sc = pn * 128 + (wi & 127);
#pragma unroll
                for (int j = 0; j < 8; ++j) v[u][j] = src[(size_t)(k8 * 8 + j) * DFF + sc]; } }
#pragma unroll
            for (int u = 0; u < 2; ++u) { const int it = it0 + u * gth; if (it < items) { const int n = it % 5632, k8 = it / 5632;
                u32x4 w; w.x = cvt_pk_bf16(v[u][0], v[u][1]); w.y = cvt_pk_bf16(v[u][2], v[u][3]); w.z = cvt_pk_bf16(v[u][4], v[u][5]); w.w = cvt_pk_bf16(v[u][6], v[u][7]);
                *(u32x4*)(dst + (size_t)n * 1024 + k8 * 8) = w; } }
        }
    }
}
__device__ __forceinline__ void late_bias2(const Params& p, int gw, int nw) {
    unsigned char* ws = p.ws; const int lane = otid() & 63;
    const float* ada = (const float*)(ws + WS_SMALL + SM_ADA); float* bias2 = (float*)(ws + WS_SMALL + SM_BIAS2);
    for (int n = gw; n < 5632; n += nw) {
        const bf16_t* wrow = (const bf16_t*)(ws + WS_GU_T) + (size_t)n * 1024;
        float a[4] = {0.f, 0.f, 0.f, 0.f};
#pragma unroll
        for (int i = 0; i < 2; ++i) {
            const int k0 = i * 512 + lane * 8; const u32x4 wv = *(const u32x4*)(wrow + k0);
            float wf[8]; unpack8(wv, wf);
#pragma unroll
            for (int b = 0; b < 4; ++b) { const float* sh = ada + b * 6144 + 3072 + k0;
#pragma unroll
                for (int j = 0; j < 8; ++j) a[b] += sh[j] * wf[j]; }
        }
#pragma unroll
        for (int b = 0; b < 4; ++b) a[b] = wave_sum(a[b]);
        if (lane == 0) {
#pragma unroll
            for (int b = 0; b < 4; ++b) bias2[b * 5632 + n] = a[b]; }
    }
}

__device__ __forceinline__ void deferred_setup(const Params& p, LAS unsigned char* lds, int bi, int nb) {
    unsigned char* ws = p.ws; const int tid = otid();
    for (int u = bi; u < NG * 8; u += nb) s5_mats(p, u >> 3, u & 7, lds);
    const int gtid = bi * 512 + tid, gth = nb * 512;
    transpose_cvt((bf16_t*)(ws + WS_WGLU_T), p.in[I_WGLU], 512, 512, 512, [](int n) { return n; }, gtid, gth);
    {
        bf16_t* dst = (bf16_t*)(ws + WS_LORA_T);
        const int items = 1536 * 32;
        for (int it = gtid; it < items; it += gth) {
            const int n = it % 1536, k8 = it / 1536, k0 = k8 * 8; float v[8];
#pragma unroll
            for (int j = 0; j < 8; ++j) { const int k = k0 + j; float x = 0.f;
                if (n < 512) { if (k < 64) x = p.in[I_W2][(size_t)k * 512 + n]; }
                else if (n < 1024) { if (k >= 64 && k < 128) x = p.in[I_A2][(size_t)(k - 64) * 512 + (n - 512)]; }
                else { if (k >= 128) x = p.in[I_G2][(size_t)(k - 128) * 512 + (n - 1024)]; }
                v[j] = x; }
            u32x4 w; w.x = cvt_pk_bf16(v[0], v[1]); w.y = cvt_pk_bf16(v[2], v[3]); w.z = cvt_pk_bf16(v[4], v[5]); w.w = cvt_pk_bf16(v[6], v[7]);
            *(u32x4*)(dst + (size_t)n * 256 + k0) = w;
        }
    }
}

__device__ __forceinline__ void phase1(const Params& p) {
    const int tid = otid(), lane = tid & 63, gw = blockIdx.x * 8 + (tid >> 6), nw = gridDim.x * 8;
    unsigned char* ws = p.ws;
    const float* ada = (const float*)(ws + WS_SMALL + SM_ADA);
    bf16_t* A1 = (bf16_t*)(ws + WS_A1); float* rstd1 = (float*)(ws + WS_SMALL + SM_RSTD1);
    for (int row0 = gw * 4; row0 < NT; row0 += nw * 4) {
        const int b = row0 >> 13; const float* sc = ada + b * 6144 + 1024;
        f32x4 xv[4][4];
#pragma unroll
        for (int r = 0; r < 4; ++r)
#pragma unroll
            for (int i = 0; i < 4; ++i) xv[r][i] = ldnt((const f32x4*)(p.in[I_X] + (size_t)(row0 + r) * 1024 + i * 256 + lane * 4));
        f32x4 sv[4];
#pragma unroll
        for (int i = 0; i < 4; ++i) sv[i] = *(const f32x4*)(sc + i * 256 + lane * 4) + 1.0f;
#pragma unroll
        for (int r = 0; r < 4; ++r) {
            float ss = 0.f;
#pragma unroll
            for (int i = 0; i < 4; ++i) ss += xv[r][i][0] * xv[r][i][0] + xv[r][i][1] * xv[r][i][1] + xv[r][i][2] * xv[r][i][2] + xv[r][i][3] * xv[r][i][3];
            ss = wave_sum(ss);
            if (lane == 0) rstd1[row0 + r] = rsqrtf(ss * (1.0f / 1024.0f) + 1e-6f);
#pragma unroll
            for (int i = 0; i < 4; ++i) { const f32x4 a = xv[r][i] * sv[i]; u32x2 w; w.x = cvt_pk_bf16(a[0], a[1]); w.y = cvt_pk_bf16(a[2], a[3]);
                *(u32x2*)(A1 + (size_t)(row0 + r) * 1024 + i * 256 + lane * 4) = w; }
        }
    }
    float* bias1 = (float*)(ws + WS_SMALL + SM_BIAS1); float* bias2 = (float*)(ws + WS_SMALL + SM_BIAS2);
    for (int it = gw; it < 2304; it += nw) {
        const bool first = it < 2304; const int n = first ? it : it - 2304;
        const bf16_t* wrow = first ? (const bf16_t*)(ws + WS_WIN_T) + (size_t)n * 1024 : (const bf16_t*)(ws + WS_GU_T) + (size_t)n * 1024;
        const int shoff = first ? 0 : 3072;
        float a[4] = {0.f, 0.f, 0.f, 0.f};
#pragma unroll
        for (int i = 0; i < 2; ++i) {
            const int k0 = i * 512 + lane * 8; const u32x4 wv = *(const u32x4*)(wrow + k0);
            const float wf[8] = {bflo(wv.x), bfhi(wv.x), bflo(wv.y), bfhi(wv.y), bflo(wv.z), bfhi(wv.z), bflo(wv.w), bfhi(wv.w)};
#pragma unroll
            for (int b = 0; b < 4; ++b) { const float* sh = ada + b * 6144 + shoff + k0;
#pragma unroll
                for (int j = 0; j < 8; ++j) a[b] += sh[j] * wf[j]; }
        }
#pragma unroll
        for (int b = 0; b < 4; ++b) a[b] = wave_sum(a[b]);
        if (lane == 0) { float* dst = first ? bias1 : bias2; const int ld = first ? 2304 : 5632;
#pragma unroll
            for (int b = 0; b < 4; ++b) dst[b * ld + n] = a[b]; }
    }
}

__device__ __forceinline__ void phase3(const Params& p) {
    const int gtid = blockIdx.x * 512 + otid(), gth = gridDim.x * 512;
    const bf16_t* LO = (const bf16_t*)(p.ws + WS_LO); bf16_t* LA = (bf16_t*)(p.ws + WS_LA); const float* mu = p.in[I_MU] + 1536;
    const int c0 = (gtid & 31) * 8;
    float m[8];
#pragma unroll
    for (int j = 0; j < 8; ++j) m[j] = mu[c0 + j];
    for (int base = gtid; base < NT * 32; base += 4 * gth) {
        u32x4 cur[4], prv[4];
#pragma unroll
        for (int k = 0; k < 4; ++k) { const int it = base + k * gth; cur[k] = (u32x4){0u, 0u, 0u, 0u}; prv[k] = (u32x4){0u, 0u, 0u, 0u};
            if (it < NT * 32) { const int t = it >> 5; cur[k] = ldnt((const u32x4*)(LO + (size_t)t * 256 + c0)); if ((t & (SEQ - 1)) != 0) prv[k] = *(const u32x4*)(LO + (size_t)(t - 1) * 256 + c0); } }
#pragma unroll
        for (int k = 0; k < 4; ++k) { const int it = base + k * gth;
            if (it < NT * 32) { const int t = it >> 5; float zc[8], zp[8], o[8]; unpack8(cur[k], zc); unpack8(prv[k], zp);
#pragma unroll
                for (int j = 0; j < 8; ++j) { const float z = zc[j] + m[j] * (zp[j] - zc[j]); o[j] = (c0 < 64) ? tanhf_(z) : (c0 < 128 ? z : sigmoidf_(z)); }
                *(u32x4*)(LA + (size_t)t * 256 + c0) = pack8a(o); } }
    }
}

__device__ __forceinline__ void s5_carry(const Params& p, int item) {
    const int lane = otid() & 63, g = item >> 2, b = item & 3;
    const float dt = expf(p.in[I_SLDT][g]); const float are = p.in[I_SARE][g * 64 + lane], aim = p.in[I_SAIM][g * 64 + lane];
    const float mag = expf(16.0f * dt * are), ang = 16.0f * dt * aim, ar = mag * cosf(ang), ai = mag * sinf(ang);
    const bf16_t* SLOC = (const bf16_t*)(p.ws + WS_SLOC); bf16_t* USIN = (bf16_t*)(p.ws + WS_USIN);
    float sr = 0.f, si = 0.f;
    const size_t r0 = (size_t)g * 2048 + b * 512;
    for (int c0 = 0; c0 < 512; c0 += 32) {
        unsigned short lr[32], li[32];
#pragma unroll
        for (int j = 0; j < 32; ++j) { lr[j] = SLOC[(r0 + c0 + j) * 128 + lane]; li[j] = SLOC[(r0 + c0 + j) * 128 + 64 + lane]; }
#pragma unroll
        for (int j = 0; j < 32; ++j) {
            bf16_t* dst = USIN + (r0 + c0 + j) * 384 + 256;
            dst[lane] = f2bf(sr); dst[64 + lane] = f2bf(si);
            const float nr = ar * sr - ai * si + bf2f(lr[j]), ni = ar * si + ai * sr + bf2f(li[j]);
            sr = nr; si = ni;
        }
    }
}

__device__ __forceinline__ void rwkv_prepass(const Params& p, int cidx) {
    const int lane = otid() & 63, c0 = lane * 8;
    unsigned char* ws = p.ws;
    const bf16_t* R = (const bf16_t*)(ws + WS_R); const bf16_t* K = (const bf16_t*)(ws + WS_K); const bf16_t* V = (const bf16_t*)(ws + WS_V);
    const bf16_t* W = (const bf16_t*)(ws + WS_W); const bf16_t* AA = (const bf16_t*)(ws + WS_AA);
    bf16_t* WR = (bf16_t*)(ws + WS_WR); bf16_t* KP = (bf16_t*)(ws + WS_KP); bf16_t* AL = (bf16_t*)(ws + WS_AL); bf16_t* BE = (bf16_t*)(ws + WS_BE); bf16_t* VS = (bf16_t*)(ws + WS_VS);
    f32x4* SC = (f32x4*)(ws + WS_SC);
    (void)cidx;
    float mur[8], muk[8], muv[8], kkc[8], kac[8], rkc[8];
#pragma unroll
    for (int j = 0; j < 8; ++j) { mur[j] = p.in[I_MU][c0 + j]; muk[j] = p.in[I_MU][512 + c0 + j]; muv[j] = p.in[I_MU][1024 + c0 + j]; kkc[j] = p.in[I_KK][c0 + j]; kac[j] = p.in[I_KA][c0 + j]; rkc[j] = p.in[I_RK][c0 + j]; }
    struct Row { u32x4 r, k, v, a, w; };
#define PRE_LD(d, t) do { const size_t e_ = (size_t)(t) * 512 + c0; d.r = ldnt((const u32x4*)(R + e_)); d.k = ldnt((const u32x4*)(K + e_)); d.v = ldnt((const u32x4*)(V + e_)); d.a = ldnt((const u32x4*)(AA + e_)); \
        d.w = *(const u32x4*)(W + e_); } while (0)
    const int gw_ = blockIdx.x * 8 + (otid() >> 6), nw_ = gridDim.x * 8;
    for (int it = gw_; it < NT / 8; it += nw_) {
        const int t0 = it * 8;
        float rp[8], kp[8], vp[8];
        if ((t0 & (SEQ - 1)) != 0) { const size_t e = (size_t)(t0 - 1) * 512 + c0; unpack8(*(const u32x4*)(R + e), rp); unpack8(*(const u32x4*)(K + e), kp); unpack8(*(const u32x4*)(V + e), vp); }
        else {
#pragma unroll
            for (int j = 0; j < 8; ++j) { rp[j] = 0.f; kp[j] = 0.f; vp[j] = 0.f; } }
        Row cur, nxt; PRE_LD(cur, t0);
#pragma unroll
        for (int tt = 0; tt < 8; ++tt) {
            const int t = t0 + tt;
            if (tt + 1 < 8) PRE_LD(nxt, t + 1);
            float rc[8], kc[8], vc[8], a[8]; unpack8(cur.r, rc); unpack8(cur.k, kc); unpack8(cur.v, vc); unpack8(cur.a, a);
            float w[8]; unpack8(cur.w, w);
#pragma unroll
            for (int j = 0; j < 8; ++j) w[j] = __expf(-w[j]);
            float r[8], k[8], v[8], kk[8], k2[8], be[8], o[8]; float ss = 0.f;
#pragma unroll
            for (int j = 0; j < 8; ++j) { r[j] = rc[j] + mur[j] * (rp[j] - rc[j]); k[j] = kc[j] + muk[j] * (kp[j] - kc[j]); v[j] = vc[j] + muv[j] * (vp[j] - vc[j]); kk[j] = k[j] * kkc[j]; ss += kk[j] * kk[j]; }
            ss = red8(ss); const float inv = 1.0f / fmaxf(sqrtf(ss), 1e-12f);
            float br = 0.f, kr = 0.f, bc = 0.f;
#pragma unroll
            for (int j = 0; j < 8; ++j) { kk[j] *= inv; k2[j] = k[j] * (1.0f + (a[j] - 1.0f) * kac[j]); be[j] = kk[j] * a[j]; br += be[j] * r[j]; kr += k2[j] * r[j]; bc += r[j] * k2[j] * rkc[j]; }
            br = red8(br); kr = red8(kr); bc = red8(bc);
            const size_t e = (size_t)t * 512 + c0;
#pragma unroll
            for (int j = 0; j < 8; ++j) o[j] = w[j] * r[j];
            *(u32x4*)(WR + e) = pack8a(o); *(u32x4*)(KP + e) = pack8a(k2);
#pragma unroll
            for (int j = 0; j < 8; ++j) o[j] = -kk[j];
            *(u32x4*)(AL + e) = pack8a(o); *(u32x4*)(BE + e) = pack8a(be); *(u32x4*)(VS + e) = pack8a(v);
            if ((lane & 7) == 0) SC[(size_t)t * 8 + (lane >> 3)] = (f32x4){br, kr, bc, 0.f};
#pragma unroll
            for (int j = 0; j < 8; ++j) { rp[j] = rc[j]; kp[j] = kc[j]; vp[j] = vc[j]; }
            cur = nxt;
        }
    }
#undef PRE_LD
}

constexpr int CH = 32;
constexpr int HSEQ = SEQ / 2;
constexpr int CB_AL = 0, CB_BE = 8192, CB_KP = 16384, CB_WR = 24576, CB_W = 32768, CB_VS = 40960, CB_Y = 49152, CB_BYTES = 53248;
struct ScanRegs { u32x4 al, be, kp, wr, w; f32x2 sca, scb; u32x4 vs; };
__device__ __forceinline__ void scan_load(const Params& p, ScanRegs& r, int lt, size_t tg0, int h, int row0, bool phi) {
    unsigned char* ws = p.ws;
    const int tok = lt >> 3, part = lt & 7; const size_t e = (tg0 + tok) * 512 + h * 64 + part * 8;
    r.al = *(const u32x4*)((const bf16_t*)(ws + WS_AL) + e); r.be = *(const u32x4*)((const bf16_t*)(ws + WS_BE) + e);
    r.kp = *(const u32x4*)((const bf16_t*)(ws + WS_KP) + e); r.wr = *(const u32x4*)((const bf16_t*)(ws + WS_WR) + e);
    r.w = *(const u32x4*)((const bf16_t*)(ws + WS_W) + e);
    { const f32x4 s4 = ((const f32x4*)(ws + WS_SC))[(tg0 + tok) * 8 + h]; r.sca = (f32x2){s4[0], s4[1]}; }
    if (lt < 4 * CH) { r.vs = (u32x4){0u, 0u, 0u, 0u}; const f32x4 s4 = ((const f32x4*)(ws + WS_SC))[(tg0 + (lt >> 2)) * 8 + h]; r.scb = (f32x2){s4[0], s4[1]};
        if (!phi) r.vs = *(const u32x4*)((const bf16_t*)(ws + WS_VS) + (tg0 + (lt >> 2)) * 512 + h * 64 + row0 + (lt & 3) * 8); }
}
__device__ __forceinline__ void st_bf8_f32(LAS unsigned char* dst, u32x4 v) {
    *(LAS f32x4*)dst = (f32x4){bflo(v.x), bfhi(v.x), bflo(v.y), bfhi(v.y)}; *(LAS f32x4*)(dst + 16) = (f32x4){bflo(v.z), bfhi(v.z), bflo(v.w), bfhi(v.w)};
}
__device__ __forceinline__ void scan_store(LAS unsigned char* buf, const ScanRegs& r, int lt) {
    const int o = (lt >> 3) * 256 + (lt & 7) * 32;
    st_bf8_f32(buf + CB_AL + o, r.al); st_bf8_f32(buf + CB_BE + o, r.be); st_bf8_f32(buf + CB_KP + o, r.kp);
    { const float br = r.sca[0]; float a[8], wv[8]; unpack8(r.al, a); unpack8(r.wr, wv);
        *(LAS f32x4*)(buf + CB_WR + o) = (f32x4){wv[0] + br * a[0], wv[1] + br * a[1], wv[2] + br * a[2], wv[3] + br * a[3]};
        *(LAS f32x4*)(buf + CB_WR + o + 16) = (f32x4){wv[4] + br * a[4], wv[5] + br * a[5], wv[6] + br * a[6], wv[7] + br * a[7]}; }
    { float e8[8]; unpack8(r.w, e8);
        *(LAS f32x4*)(buf + CB_W + o) = (f32x4){__expf(-e8[0]), __expf(-e8[1]), __expf(-e8[2]), __expf(-e8[3])}; *(LAS f32x4*)(buf + CB_W + o + 16) = (f32x4){__expf(-e8[4]), __expf(-e8[5]), __expf(-e8[6]), __expf(-e8[7])}; }
    if (lt < 4 * CH) { LAS unsigned char* d = buf + CB_VS + (lt >> 2) * 256 + (lt & 3) * 64; const float kr = r.scb[1];
        float v[8]; unpack8(r.vs, v);
#pragma unroll
        for (int i = 0; i < 8; i += 2) *(LAS f32x4*)(d + i * 8) = (f32x4){v[i], v[i] * kr, v[i + 1], v[i + 1] * kr}; }
}
__device__ __forceinline__ void scan_yout(LAS unsigned char* buf, int tid, bf16_t* dst  ) {
    if (tid < 4 * CH) {
        const int tok = tid >> 2, qt = tid & 3;
        const f32x4 a = *(const LAS f32x4*)(buf + CB_Y + tok * 128 + qt * 32), b = *(const LAS f32x4*)(buf + CB_Y + tok * 128 + qt * 32 + 16);
        *(u32x4*)(dst + (size_t)tok * 512 + qt * 8) = pack8(a, b);
    }
}
__device__ __forceinline__ void rwkv_scan(const Params& p, int sb, LAS unsigned char* lds) {
    const int tid = otid(), wave = __builtin_amdgcn_readfirstlane(tid >> 6), lane = tid & 63;
    const int jj = sb >> 3, hh = (sb & 7) * 4 + jj / 6, role = jj % 6, b = hh >> 3, h = hh & 7, row0 = (role & 1) * 32, kind = role >> 1;
    const bool phi = (kind == 2);
    const size_t tg = (size_t)b * SEQ + (kind == 0 ? 0 : HSEQ);
    bf16_t* ydst = phi ? (bf16_t*)(p.ws + WS_YPHI) + ((size_t)b * HSEQ) * 512 + h * 64 + row0 : (bf16_t*)(p.ws + WS_Y) + tg * 512 + h * 64 + row0;
    constexpr int NCH = HSEQ / CH;
    const bool loader = wave >= 4; const int lt = tid - 256;
    ScanRegs rg;
    if (loader) { scan_load(p, rg, lt, tg, h, row0, phi); scan_store(lds, rg, lt); scan_load(p, rg, lt, tg + CH, h, row0, phi); }
    __syncthreads();
    const int rl = (wave & 3) * 8 + (lane >> 3), ko = lane & 7;
    float S[8];
#pragma unroll
    for (int i = 0; i < 8; ++i) S[i] = (phi && (row0 + rl == ko * 8 + i)) ? 1.f : 0.f;
    for (int c = 0; c < NCH; ++c) {
        LAS unsigned char* buf = lds + (c & 1) * CB_BYTES;
        LAS unsigned char* nb = lds + ((c + 1) & 1) * CB_BYTES;
        if (loader) {
            if (c > 0) scan_yout(nb, lt, ydst + (size_t)(c - 1) * CH * 512);
            if (c + 1 < NCH) scan_store(nb, rg, lt);
            if (c + 2 < NCH) scan_load(p, rg, lt, tg + (size_t)(c + 2) * CH, h, row0, phi);
        } else {
            __builtin_amdgcn_s_setprio(3);
            const LAS unsigned char* bq = buf + ko * 32;
            struct StepIn { f32x4 al0, al1, wq0, wq1, be0, be1, kp0, kp1, w0, w1; f32x2 rec; };
#define SCAN_LD(d, s) do { d.al0 = *(const LAS f32x4*)(bq + CB_AL + (s) * 256); d.al1 = *(const LAS f32x4*)(bq + CB_AL + (s) * 256 + 16); d.wq0 = *(const LAS f32x4*)(bq + CB_WR + (s) * 256); d.wq1 = *(const LAS f32x4*)(bq + CB_WR + (s) * 256 + 16); \
        d.be0 = *(const LAS f32x4*)(bq + CB_BE + (s) * 256); d.be1 = *(const LAS f32x4*)(bq + CB_BE + (s) * 256 + 16); d.kp0 = *(const LAS f32x4*)(bq + CB_KP + (s) * 256); d.kp1 = *(const LAS f32x4*)(bq + CB_KP + (s) * 256 + 16); \
        d.w0 = *(const LAS f32x4*)(bq + CB_W + (s) * 256); d.w1 = *(const LAS f32x4*)(bq + CB_W + (s) * 256 + 16); d.rec = *(const LAS f32x2*)(buf + CB_VS + (s) * 256 + rl * 8); } while (0)
            StepIn cur, n1;
            SCAN_LD(cur, 0);
#pragma unroll
            for (int s = 0; s < CH; ++s) {
                if (s + 1 < CH) SCAN_LD(n1, s + 1);
                const float al[8] = {cur.al0[0], cur.al0[1], cur.al0[2], cur.al0[3], cur.al1[0], cur.al1[1], cur.al1[2], cur.al1[3]};
                const float wq[8] = {cur.wq0[0], cur.wq0[1], cur.wq0[2], cur.wq0[3], cur.wq1[0], cur.wq1[1], cur.wq1[2], cur.wq1[3]};
                const float be[8] = {cur.be0[0], cur.be0[1], cur.be0[2], cur.be0[3], cur.be1[0], cur.be1[1], cur.be1[2], cur.be1[3]};
                const float kp[8] = {cur.kp0[0], cur.kp0[1], cur.kp0[2], cur.kp0[3], cur.kp1[0], cur.kp1[1], cur.kp1[2], cur.kp1[3]};
                const float w[8] = {cur.w0[0], cur.w0[1], cur.w0[2], cur.w0[3], cur.w1[0], cur.w1[1], cur.w1[2], cur.w1[3]};
                f32x2 t0 = (f32x2){S[0], S[1]} * (f32x2){al[0], al[1]}, t1 = (f32x2){S[0], S[1]} * (f32x2){wq[0], wq[1]};
#pragma unroll
                for (int i = 2; i < 8; i += 2) { t0 = (f32x2){S[i], S[i + 1]} * (f32x2){al[i], al[i + 1]} + t0; t1 = (f32x2){S[i], S[i + 1]} * (f32x2){wq[i], wq[i + 1]} + t1; }
                const float sa = red8(t0[0] + t0[1]);
                const float y = red8(t1[0] + t1[1]) + cur.rec[1];
                const f32x2 sa2 = (f32x2){sa, sa}, vv2 = (f32x2){cur.rec[0], cur.rec[0]};
#pragma unroll
                for (int i = 0; i < 8; i += 2) { const f32x2 sn = (f32x2){S[i], S[i + 1]} * (f32x2){w[i], w[i + 1]} + sa2 * (f32x2){be[i], be[i + 1]} + vv2 * (f32x2){kp[i], kp[i + 1]}; S[i] = sn[0]; S[i + 1] = sn[1]; }
                *(LAS float*)(buf + CB_Y + s * 128 + rl * 4) = y;
                cur = n1;
            }
#undef SCAN_LD
            __builtin_amdgcn_s_setprio(0);
        }
        __syncthreads();
    }
    if (loader) scan_yout(lds + ((NCH - 1) & 1) * CB_BYTES, lt, ydst + (size_t)(NCH - 1) * CH * 512);
    if (kind == 0 && wave < 4) { float* d = (float*)(p.ws + WS_SH) + ((size_t)hh * 64 + row0 + rl) * 64 + ko * 8;
        *(f32x4*)d = (f32x4){S[0], S[1], S[2], S[3]}; *(f32x4*)(d + 4) = (f32x4){S[4], S[5], S[6], S[7]}; }
    __syncthreads();
}
typedef float f32x16 __attribute__((ext_vector_type(16)));
__device__ __forceinline__ void rwkv_fixup(const Params& p) {
    const int tid = otid(), lane = tid & 63, gw = blockIdx.x * 8 + (tid >> 6), nw = gridDim.x * 8, r = lane & 31, hf = lane >> 5;
    const bf16_t* YPHI = (const bf16_t*)(p.ws + WS_YPHI); const float* SH = (const float*)(p.ws + WS_SH); bf16_t* Y = (bf16_t*)(p.ws + WS_Y);
    for (int u = gw; u < 32 * (HSEQ / 32); u += nw) {
        const int hh = u / (HSEQ / 32), tile = u % (HSEQ / 32), b = hh >> 3, h = hh & 7;
        const size_t tphi = (size_t)b * HSEQ + tile * 32, t0 = (size_t)b * SEQ + HSEQ + tile * 32;
        bf16x8 af[4];
#pragma unroll
        for (int s = 0; s < 4; ++s) af[s] = *(const bf16x8*)(YPHI + (tphi + r) * 512 + h * 64 + 16 * s + 8 * hf);
#pragma unroll
        for (int vt = 0; vt < 2; ++vt) {
            const float* srow = SH + ((size_t)hh * 64 + vt * 32 + r) * 64;
            f32x16 acc;
#pragma unroll
            for (int i = 0; i < 16; ++i) acc[i] = 0.f;
#pragma unroll
            for (int s = 0; s < 4; ++s) {
                const f32x4 x0 = *(const f32x4*)(srow + 16 * s + 8 * hf), x1 = *(const f32x4*)(srow + 16 * s + 8 * hf + 4);
                const u32x4 w = pack8(x0, x1); bf16x8 bfr = __builtin_bit_cast(bf16x8, w);
                acc = __builtin_amdgcn_mfma_f32_32x32x16_bf16(af[s], bfr, acc, 0, 0, 0);
            }
#pragma unroll
            for (int i = 0; i < 16; ++i) {
                const int row = (i & 3) + 8 * (i >> 2) + 4 * hf;
                bf16_t* yp = Y + (t0 + row) * 512 + h * 64 + vt * 32 + r;
                *yp = f2bf(bf2f(*yp) + acc[i]);
            }
        }
    }
}

__device__ __forceinline__ void phase8(const Params& p) {
    const int tid = otid(), lane = tid & 63, c0 = lane * 8, gw = blockIdx.x * 8 + (tid >> 6), nw = gridDim.x * 8;
    unsigned char* ws = p.ws;
    const bf16_t* Y = (const bf16_t*)(ws + WS_Y); const bf16_t* VS = (const bf16_t*)(ws + WS_VS); const bf16_t* G = (const bf16_t*)(ws + WS_G); const bf16_t* GLUO = (const bf16_t*)(ws + WS_GLUO);
    const f32x4* SC = (const f32x4*)(ws + WS_SC);
    bf16_t* MIX = (bf16_t*)(ws + WS_MIX);
    float lnw[8], lnb[8];
#pragma unroll
    for (int j = 0; j < 8; ++j) { lnw[j] = p.in[I_LNW][c0 + j]; lnb[j] = p.in[I_LNB][c0 + j]; }
    struct Row { u32x4 y, v, g; f32x4 sc; };
#define P8_LD(d, t) do { const size_t e_ = (size_t)(t) * 512 + c0; d.y = ldnt((const u32x4*)(Y + e_)); d.v = ldnt((const u32x4*)(VS + e_)); d.g = ldnt((const u32x4*)(G + e_)); \
        d.sc = SC[(size_t)(t) * 8 + (lane >> 3)]; } while (0)
    const int per = (NT + nw - 1) / nw, tbeg = gw * per, tend = (tbeg + per < NT) ? tbeg + per : NT;
    if (tbeg >= NT) return;
    Row cur, nxt; P8_LD(cur, tbeg);
    for (int t = tbeg; t < tend; ++t) {
        if (t + 1 < tend) P8_LD(nxt, t + 1);
        float y[8], v[8], g[8], o[8]; unpack8(cur.y, y); unpack8(cur.v, v); unpack8(cur.g, g);
        float sm = 0.f;
#pragma unroll
        for (int j = 0; j < 8; ++j) sm += y[j];
        const float mean = red8(sm) * (1.0f / 64.0f); float sq = 0.f;
#pragma unroll
        for (int j = 0; j < 8; ++j) { y[j] -= mean; sq += y[j] * y[j]; }
        const float rstd = rsqrtf(red8(sq) * (1.0f / 64.0f) + 64e-5f), bc = cur.sc[2];
#pragma unroll
        for (int j = 0; j < 8; ++j) o[j] = (y[j] * rstd * lnw[j] + lnb[j] + bc * v[j]) * g[j];
        *(u32x4*)(MIX + (size_t)t * 1024 + c0) = pack8a(o);
        cur = nxt;
    }
#undef P8_LD
}

__device__ __forceinline__ void s5_mix_half(const Params& p, int b2, int G2) {
    const int tid = otid(), lane = tid & 63, c0 = lane * 8, gw = b2 * 8 + (tid >> 6), nw = G2 * 8;
    const bf16_t* GLUO = (const bf16_t*)(p.ws + WS_GLUO); const float* rss5 = (const float*)(p.ws + WS_SMALL + SM_RSP5); bf16_t* MIX = (bf16_t*)(p.ws + WS_MIX);
    float gain[8];
#pragma unroll
    for (int j = 0; j < 8; ++j) gain[j] = p.in[I_SGAIN][c0 + j];
    for (int t0 = gw * 4; t0 < NT; t0 += nw * 4) {
        u32x4 gv[4]; float rs[4];
#pragma unroll
        for (int k = 0; k < 4; ++k) { gv[k] = *(const u32x4*)(GLUO + (size_t)(t0 + k) * 512 + c0); const f32x4* rp = (const f32x4*)(rss5 + (size_t)(t0 + k) * 8); const f32x4 q4 = rp[0] + rp[1]; rs[k] = rsqrtf(((q4[0] + q4[1]) + (q4[2] + q4[3])) * (1.0f / 512.0f) + 1e-6f); }
#pragma unroll
        for (int k = 0; k < 4; ++k) { float o[8]; unpack8(gv[k], o);
#pragma unroll
            for (int j = 0; j < 8; ++j) o[j] = o[j] * rs[k] * gain[j];
            *(u32x4*)(MIX + (size_t)(t0 + k) * 1024 + 512 + c0) = pack8a(o); }
    }
}

__device__ __forceinline__ void phase12(const Params& p) {
    const int tid = otid(), lane = tid & 63, gw = blockIdx.x * 8 + (tid >> 6), nw = gridDim.x * 8;
    const float* rss3 = (const float*)(p.ws + WS_RSP3); const bf16_t* X2 = (const bf16_t*)(p.ws + WS_X2B);
    f32x4 g[4];
#pragma unroll
    for (int i = 0; i < 4; ++i) g[i] = *(const f32x4*)(p.in[I_FGAIN] + i * 256 + lane * 4);
    for (int row0 = gw * 2; row0 < NT; row0 += nw * 2) {
        u32x2 xb[2][4]; float rs[2];
#pragma unroll
        for (int r = 0; r < 2; ++r) { const f32x4* rp = (const f32x4*)(rss3 + (size_t)(row0 + r) * 16); const f32x4 q4 = (rp[0] + rp[1]) + (rp[2] + rp[3]); rs[r] = rsqrtf(((q4[0] + q4[1]) + (q4[2] + q4[3])) * (1.0f / 1024.0f) + 1e-6f);
#pragma unroll
            for (int i = 0; i < 4; ++i) xb[r][i] = ldnt((const u32x2*)(X2 + (size_t)(row0 + r) * 1024 + i * 256 + lane * 4)); }
#pragma unroll
        for (int r = 0; r < 2; ++r)
#pragma unroll
            for (int i = 0; i < 4; ++i) { const f32x4 v = (f32x4){bflo(xb[r][i].x), bfhi(xb[r][i].x), bflo(xb[r][i].y), bfhi(xb[r][i].y)};
                stnt((f32x4*)(p.out + (size_t)(row0 + r) * 1024 + i * 256 + lane * 4), v * rs[r] * g[i]); }
    }
}

__device__ __forceinline__ void fast_barrier(unsigned* ctr, unsigned target, unsigned ep) {
    asm volatile("s_waitcnt vmcnt(0) lgkmcnt(0)" ::: "memory");
    __syncthreads();
    if (otid() == 0) {
        __builtin_amdgcn_fence(__ATOMIC_RELEASE, "agent");
        asm volatile("s_waitcnt vmcnt(0)" ::: "memory");
        const unsigned old = __hip_atomic_fetch_add(ctr, 1u, __ATOMIC_RELAXED, __HIP_MEMORY_SCOPE_AGENT);
        if (old + 1u == target) __hip_atomic_store(ctr + 64, ep, __ATOMIC_RELAXED, __HIP_MEMORY_SCOPE_AGENT);
        else while (__hip_atomic_load(ctr + 64, __ATOMIC_RELAXED, __HIP_MEMORY_SCOPE_AGENT) < ep) __builtin_amdgcn_s_sleep(1);
        __builtin_amdgcn_fence(__ATOMIC_ACQUIRE, "agent");
        asm volatile("s_waitcnt vmcnt(0)" ::: "memory");
    }
    __syncthreads();
}
__device__ __attribute__((noinline)) void gsync() { cg::this_grid().sync(); }
__global__ void __launch_bounds__(512) fwd_megakernel(Params p_arg) {
    const Params& p = *(const Params*)__builtin_amdgcn_kernarg_segment_ptr();
    extern __shared__ __attribute__((aligned(16))) unsigned char lds_raw[];
    LAS unsigned char* lds = (LAS unsigned char*)lds_raw;
    unsigned char* ws = p.ws;
    const int G = gridDim.x, blk = blockIdx.x;
    float* ada = (float*)(ws + WS_SMALL + SM_ADA);
    unsigned gep = 0; unsigned* gctr = (unsigned*)(ws + WS_SMALL + SM_CTR) + 256;
#define GBAR() do { ++gep; fast_barrier(gctr, gep * (unsigned)G, gep); } while (0)

    if (gridDim.x == 0x7fffffffu) gsync();
    REP(0) { phase0(p, lds, rep_ == 0); GBAR(); }
    REP(1) { phase1(p); GBAR(); }
    REP(2) {
        pg8::Gemm g{(const bf16_t*)(ws + WS_A1), (const bf16_t*)(ws + WS_WIN_T), NT, DIN, 1024, 1024, 1024, 30, 0};
        pg8::StaticOrder S; S.init(NT, DIN, G, blk);
        EpiIn E{(bf16_t*)(ws + WS_R), (const float*)(ws + WS_SMALL + SM_RSTD1), (const float*)(ws + WS_SMALL + SM_BIAS1)};
        pg8::gemm_phase(lds, g, S, E);
        {   const int nun = (NT / 256) * (DIN / 256), rem = nun % G;
            if (rep_ == 0) { if (rem == 0) deferred_setup(p, lds, blk, G); else if (blk >= rem) deferred_setup(p, lds, blk - rem, G - rem); } }
        GBAR();
    }
    REP(3) { phase3(p); GBAR(); }
    REP(4) {
        pg8::Gemm g{(const bf16_t*)(ws + WS_LA), (const bf16_t*)(ws + WS_LORA_T), NT, 1024, 256, 256, 256, 30, 0};
        pg8::StaticOrder S; S.init(NT, 1024, G, blk);
        EpiLora E{(bf16_t*)(ws + WS_W), (bf16_t*)(ws + WS_AA), (bf16_t*)(ws + WS_G), p.in[I_W0], p.in[I_A0], 0};
        pg8::gemm_phase(lds, g, S, E);
        GBAR();
    }
    REP(5) { rwkv_prepass(p, rep_); GBAR(); }
    REP(7) {
        const int nsc = (G >= 256) ? 192 : (G * 3) / 4;
        if (blk < nsc) { for (int sb = blk; sb < 192; sb += nsc) rwkv_scan(p, sb, lds); }
        else if (rep_ == 0) {
            const int G2 = G - nsc, b2 = blk - nsc; unsigned* sctr = (unsigned*)(ws + WS_SMALL + SM_CTR) + 512;
            {   pg8::Gemm g2{(const bf16_t*)(ws + WS_USIN), (const bf16_t*)(ws + WS_S5W), 65536, 256, 256, 384, 256, 3, (size_t)256 * 256 * 2};
                pg8::StaticOrder S2; S2.init(65536, 256, G2, b2);
                EpiS1 E2{(bf16_t*)(ws + WS_SLOC)};
                pg8::gemm_phase(lds, g2, S2, E2); }
            fast_barrier(sctr, (unsigned)G2, 1u);
            for (int it = b2 + (otid() >> 6) * G2; it < 128; it += 8 * G2) s5_carry(p, it);
            fast_barrier(sctr, 2u * (unsigned)G2, 2u);
            {   pg8::Gemm g{(const bf16_t*)(ws + WS_USIN), (const bf16_t*)(ws + WS_S5TV), 65536, 256, 384, 384, 384, 3, (size_t)256 * 384 * 2};
                pg8::StaticOrder S; S.init(65536, 256, G2, b2);
                EpiS2 E{(const bf16_t*)(ws + WS_USIN), (bf16_t*)(ws + WS_ZZ), p.in[I_SD]};
                pg8::gemm_phase(lds, g, S, E); }
            fast_barrier(sctr, 3u * (unsigned)G2, 3u);
            {   pg8::Gemm g{(const bf16_t*)(ws + WS_ZZ), (const bf16_t*)(ws + WS_WGLU_T), NT, 512, 512, 512, 512, 30, 0};
                pg8::StaticOrder S; S.init(NT, 512, G2, b2);
                EpiGlu E{(const bf16_t*)(ws + WS_ZZ), (bf16_t*)(ws + WS_GLUO), p.in[I_BGLU], (float*)(ws + WS_SMALL + SM_RSP5)};
                pg8::gemm_phase(lds, g, S, E); }
            fast_barrier(sctr, 4u * (unsigned)G2, 4u);
            s5_mix_half(p, b2, G2);
            {   pg8::Gemm g{(const bf16_t*)(ws + WS_LA), (const bf16_t*)(ws + WS_LORA_T) + (size_t)1024 * 256, NT, 512, 256, 256, 256, 30, 0};
                pg8::StaticOrder S; S.init(NT, 512, G2, b2);
                EpiLora E{(bf16_t*)(ws + WS_W), (bf16_t*)(ws + WS_AA), (bf16_t*)(ws + WS_G), p.in[I_W0], p.in[I_A0], 4};
                pg8::gemm_phase(lds, g, S, E); }
            late_weights(p, b2 * 512 + otid(), G2 * 512);
            fast_barrier(sctr, 5u * (unsigned)G2, 5u);
            late_bias2(p, b2 * 8 + (otid() >> 6), G2 * 8);
        }
        GBAR();
    }
    REP(13) { rwkv_fixup(p); GBAR(); }
    REP(8) { phase8(p); GBAR(); }
    REP(9) {
        pg8::Gemm g{(const bf16_t*)(ws + WS_MIX), (const bf16_t*)(ws + WS_WOUT_T), NT, 1024, 1024, 1024, 1024, 30, 0};
        pg8::StaticOrder S; S.init(NT, 1024, G, blk);
        EpiOut E{p.in[I_X], (bf16_t*)(ws + WS_X1), (bf16_t*)(ws + WS_A2), ada, (float*)(ws + WS_SMALL + SM_RSP2)};
        pg8::gemm_phase(lds, g, S, E);
        GBAR();
    }
    REP(10) {
        pg8::Gemm g{(const bf16_t*)(ws + WS_A2), (const bf16_t*)(ws + WS_GU_T), NT, 5632, 1024, 1024, 1024, 30, 0};
        pg8::StaticOrder S; S.init(NT, 5632, G, blk);
        EpiGU E{(bf16_t*)(ws + WS_HMID), (const float*)(ws + WS_SMALL + SM_RSP2), (const float*)(ws + WS_SMALL + SM_BIAS2)};
        pg8::gemm_phase(lds, g, S, E);
        GBAR();
    }
    REP(11) {
        pg8::Gemm g{(const bf16_t*)(ws + WS_HMID), (const bf16_t*)(ws + WS_DOWN_T), NT, 1024, DFF, DFF, DFF, 30, 0};
        pg8::StaticOrder S; S.init(NT, 1024, G, blk);
        EpiDown E{(const bf16_t*)(ws + WS_X1), (bf16_t*)(ws + WS_X2B), ada, (float*)(ws + WS_RSP3)};
        pg8::gemm_phase(lds, g, S, E);
        GBAR();
    }
    phase12(p);
}

extern "C" void kernel_launch(void* const* d_in, const int* in_sizes, int n_in, void* d_out, int out_size, void* d_ws, size_t ws_size, hipStream_t stream) {
    constexpr int LDS_BYTES = pg8::STAGE_BYTES;
    static int grid_blocks = 0;
    if (!grid_blocks) {
        int dev = 0, cus = 0, per_cu = 0;
        hipGetDevice(&dev);
        hipDeviceGetAttribute(&cus, hipDeviceAttributeMultiprocessorCount, dev);
        hipFuncSetAttribute((const void*)fwd_megakernel, hipFuncAttributeMaxDynamicSharedMemorySize, LDS_BYTES);
        hipOccupancyMaxActiveBlocksPerMultiprocessor(&per_cu, (const void*)fwd_megakernel, 512, LDS_BYTES);
        if (per_cu < 1) per_cu = 1;
        if (per_cu > 1) per_cu = 1;
        grid_blocks = cus * per_cu;
        if (ws_size < WS_END) fprintf(stderr, "kernel_launch: workspace too small: %zu < %zu\n", ws_size, (size_t)WS_END);
        (void)hipGetLastError();
    }
    hipMemsetAsync((unsigned char*)d_ws + WS_SMALL, 0, ZERO_BYTES, stream);
    Params p{};
    for (int i = 0; i < 32; ++i) p.in[i] = (const float*)d_in[i];
    p.out = (float*)d_out; p.ws = (unsigned char*)d_ws;
    void* args[] = {&p};
    hipError_t e = hipLaunchCooperativeKernel((const void*)fwd_megakernel, dim3(grid_blocks), dim3(512), args, LDS_BYTES, stream);
    if (e != hipSuccess) fprintf(stderr, "cooperative launch failed: %s (grid %d)\n", hipGetErrorString(e), grid_blocks);
}
```

```cpp
#include <hip/hip_runtime.h>
#include <hip/hip_cooperative_groups.h>
#include <cstdio>
#include <cstdint>
namespace cg = cooperative_groups;

#define LAS __attribute__((address_space(3)))
typedef unsigned short bf16_t;
typedef short bf16x8 __attribute__((ext_vector_type(8)));
typedef float f32x4 __attribute__((ext_vector_type(4)));
typedef float f32x2 __attribute__((ext_vector_type(2)));
typedef unsigned u32x4 __attribute__((ext_vector_type(4)));
typedef unsigned u32x2 __attribute__((ext_vector_type(2)));

constexpr int NT = 32768, SEQ = 8192, NB = 4, DM = 1024, DIN = 2304, DFF = 2816, NH = 8, NG = 32;
constexpr size_t MiB = 1ull << 20;
constexpr size_t WS_WIN_T = 0;
constexpr size_t WS_LORA_T = WS_WIN_T + (size_t)2304 * 1024 * 2;
constexpr size_t WS_WGLU_T = WS_LORA_T + (size_t)1536 * 256 * 2;
constexpr size_t WS_WOUT_T = WS_WGLU_T + (size_t)512 * 512 * 2;
constexpr size_t WS_GU_T = WS_WOUT_T + (size_t)1024 * 1024 * 2;
constexpr size_t WS_DOWN_T = WS_GU_T + (size_t)5632 * 1024 * 2;
constexpr size_t WS_S5W = WS_DOWN_T + (size_t)1024 * 2816 * 2;
constexpr size_t WS_S5TV = WS_S5W + (size_t)32 * 256 * 256 * 2;
constexpr size_t WS_WEND = WS_S5TV + (size_t)32 * 256 * 384 * 2;
static_assert(WS_WEND <= 36 * MiB, "weights region");
constexpr size_t WS_SMALL = 36 * MiB;
constexpr size_t SM_CTR = 0;
constexpr size_t ZERO_BYTES = 4096;
constexpr size_t SM_ADA = ZERO_BYTES;
constexpr size_t SM_BIAS1 = SM_ADA + 4 * 6144 * 4;
constexpr size_t SM_BIAS2 = SM_BIAS1 + 4 * 2304 * 4;
constexpr size_t SM_RSTD1 = SM_BIAS2 + 4 * 5632 * 4;
constexpr size_t SM_RSP5 = SM_RSTD1 + NT * 4;
constexpr size_t SM_RSP2 = SM_RSP5 + (size_t)NT * 8 * 4;
constexpr size_t SM_END = SM_RSP2 + (size_t)NT * 16 * 4;
static_assert(SM_END <= 4 * MiB, "small region");
constexpr size_t WS_A1 = 40 * MiB;
constexpr size_t WS_WR = 40 * MiB;
constexpr size_t WS_KP = 72 * MiB;
constexpr size_t WS_MIX = 200 * MiB;
constexpr size_t WS_R = 104 * MiB;
constexpr size_t WS_K = 136 * MiB;
constexpr size_t WS_V = 168 * MiB;
constexpr size_t WS_YPHI = 104 * MiB;
constexpr size_t WS_SH = 120 * MiB;
constexpr size_t WS_ZZ = 136 * MiB;
constexpr size_t WS_GLUO = 168 * MiB;
constexpr size_t WS_LO = 200 * MiB;
constexpr size_t WS_SLOC = 200 * MiB;
constexpr size_t WS_USIN = 216 * MiB;
constexpr size_t WS_LA = 264 * MiB;
constexpr size_t WS_W = 280 * MiB;
constexpr size_t WS_AA = 344 * MiB;
constexpr size_t WS_Y = 344 * MiB;
constexpr size_t WS_G = 376 * MiB;
constexpr size_t WS_AL = 408 * MiB;
constexpr size_t WS_BE = 440 * MiB;
constexpr size_t WS_VS = 472 * MiB;
constexpr size_t WS_SC = 504 * MiB;
constexpr size_t WS_X1 = 104 * MiB;
constexpr size_t WS_X2B = 168 * MiB;
constexpr size_t WS_A2 = 40 * MiB;
constexpr size_t WS_HMID = 296 * MiB;
constexpr size_t WS_RSP3 = 508 * MiB;
constexpr size_t WS_END = 510 * MiB;
#ifndef DUP
#define DUP 0
#endif
#define REP(bit) for (int rep_ = 0; rep_ < (((DUP) >> (bit)) & 1) + 1; ++rep_)

struct Params {
    const float* in[32];
    float* out;
    unsigned char* ws;
};

__device__ __forceinline__ float bf2f(unsigned short b) { return __uint_as_float(((unsigned)b) << 16); }
__device__ __forceinline__ unsigned short f2bf(float f) { unsigned u = __float_as_uint(f); u += 0x7FFFu + ((u >> 16) & 1u); return (unsigned short)(u >> 16); }
__device__ __forceinline__ unsigned cvt_pk_bf16(float lo, float hi) { unsigned r; asm volatile("v_cvt_pk_bf16_f32 %0, %1, %2" : "=v"(r) : "v"(lo), "v"(hi)); return r; }
__device__ __forceinline__ float bflo(unsigned w) { return __uint_as_float(w << 16); }
__device__ __forceinline__ float bfhi(unsigned w) { return __uint_as_float(w & 0xffff0000u); }
__device__ __forceinline__ float sigmoidf_(float x) { return 1.0f / (1.0f + __expf(-x)); }
__device__ __forceinline__ float siluf_(float x) { return x * sigmoidf_(x); }
__device__ __forceinline__ float tanhf_(float x) { const float e = __expf(2.0f * x); return 1.0f - 2.0f / (e + 1.0f); }
__device__ __forceinline__ float gelu_tanh(float y) { const float u = 0.7978845608028654f * (y + 0.044715f * y * y * y); return 0.5f * y * (1.0f + tanhf_(u)); }
__device__ __forceinline__ float wave_sum(float v) {
#pragma unroll
    for (int o = 32; o >= 1; o >>= 1) v += __shfl_xor(v, o);
    return v;
}
template <int CTRL> __device__ __forceinline__ float dpp_f(float x) { return __builtin_bit_cast(float, __builtin_amdgcn_update_dpp(0, __builtin_bit_cast(int, x), CTRL, 0xF, 0xF, false)); }
__device__ __forceinline__ float red16(float x) { x += dpp_f<0x128>(x); x += dpp_f<0x124>(x); x += dpp_f<0x122>(x); x += dpp_f<0x121>(x); return x; }

__device__ __forceinline__ float red8(float x) { x += dpp_f<0xB1>(x); x += dpp_f<0x4E>(x); x += dpp_f<0x141>(x); return x; }
__device__ __forceinline__ void unpack8(u32x4 v, float (&o)[8]) { o[0] = bflo(v.x); o[1] = bfhi(v.x); o[2] = bflo(v.y); o[3] = bfhi(v.y); o[4] = bflo(v.z); o[5] = bfhi(v.z); o[6] = bflo(v.w); o[7] = bfhi(v.w); }
__device__ __forceinline__ u32x4 pack8a(const float (&v)[8]) { u32x4 w; w.x = cvt_pk_bf16(v[0], v[1]); w.y = cvt_pk_bf16(v[2], v[3]); w.z = cvt_pk_bf16(v[4], v[5]); w.w = cvt_pk_bf16(v[6], v[7]); return w; }
template <class T> __device__ __forceinline__ T ldnt(const T* p) { return __builtin_nontemporal_load(p); }
template <class T> __device__ __forceinline__ void stnt(T* p, T v) { __builtin_nontemporal_store(v, p); }
__device__ __forceinline__ int otid() { int t = threadIdx.x; asm volatile("" : "+v"(t)); return t; }
namespace pg8 {
constexpr int BM = 256, BK = 64, HALF = 128, HTB = HALF * BK * 2, STAGE_BYTES = 8 * HTB, NXCD = 8, WGM = 8;
__host__ __device__ __forceinline__ int lds_byte(int r, int c) { const int st = (r >> 4) * 2 + (c >> 5), rr = r & 15, cc = c & 31, ob = rr * 64 + cc * 2; return st * 1024 + (ob ^ (((ob >> 9) & 1) << 5)); }
__host__ __device__ __forceinline__ void stage_rc(int b, int& R, int& C) { const int st = b / 1024, sb = b % 1024, swz = sb ^ (((sb >> 9) & 1) << 5); R = (st >> 1) * 16 + swz / 64; C = (st & 1) * 32 + (swz % 64) / 2; }
__host__ __device__ __forceinline__ int perm32(int rho) { const int n = rho >> 4, i = rho & 15; return 8 * (i >> 2) + 4 * n + (i & 3); }

struct Unit { int pm, pn; };
struct Gemm { const bf16_t* A; const bf16_t* Bt; int M, N, K, lda, ldb, gm; size_t gstrideB; };

struct StaticOrder {
    int nM, nN, nwg, G, c;
    __host__ __device__ void init(int M, int N, int G_, int c_) { nM = M / BM; nN = N / BM; nwg = nM * nN; G = G_; c = c_; }
    __host__ __device__ bool next(int i, Unit& u) const {
        const long L = (long)i * G + c; if (L >= nwg) return false;
        int wgid = (int)L; { const int q = nwg / NXCD, r = nwg % NXCD, xcd = wgid % NXCD, off = wgid / NXCD; wgid = (xcd < r ? xcd * (q + 1) : r * (q + 1) + (xcd - r) * q) + off; }
        const int nig = WGM * nN, gid = wgid / nig, fm = gid * WGM, gsz = (nM - fm) < WGM ? (nM - fm) : WGM;
        u.pm = fm + ((wgid % nig) % gsz); u.pn = (wgid % nig) / gsz; return true;
    }
};

template <class Epi, class Sched>
__device__ __forceinline__ void gemm_phase(LAS unsigned char* lds, const Gemm g, const Sched& S, const Epi& E) {
    int tid_ = otid(); asm volatile("" : "+v"(tid_));
    const int tid = tid_, wid = __builtin_amdgcn_readfirstlane(tid >> 6), lane = tid & 63, wr = wid >> 2, wc = wid & 3, fr = lane & 15, fq = lane >> 4;
    const int K = g.K, nt = K / BK;
    unsigned voffA, voffB;
    { int R, C; stage_rc(tid * 16, R, C); const int Rb = Epi::PERM ? ((R & ~31) + perm32(R & 31)) : R;
        voffA = (unsigned)(R * g.lda + C) * 2u; voffB = (unsigned)(Rb * g.ldb + C) * 2u; }
    const size_t dA = (size_t)64 * g.lda * 2, dB = (size_t)64 * g.ldb * 2;
    const size_t kstep = (size_t)(BK * 2);
    const size_t hstepA = (size_t)HALF * g.lda * 2, hstepB = (size_t)HALF * g.ldb * 2;
    const size_t tstepA = 2 * hstepA, tstepB = 2 * hstepB;
    const unsigned ldsw = (unsigned)wid * 1024u;
    const int aoff = lds_byte(wr * 64 + fr, fq * 8), boff = lds_byte(wc * 32 + fr, fq * 8);
#define PG8_SA(b, h) (((b) * 2 + (h)) * HTB)
#define PG8_SB(b, h) ((4 + (b) * 2 + (h)) * HTB)
#define PG8_STAGE(bufoff, gbase, voff) do { _Pragma("unroll") for (int _i = 0; _i < 2; ++_i) \
        __builtin_amdgcn_global_load_lds((const unsigned*)((const char*)(gbase) + (size_t)_i * PG8_D_##voff + (voff)), (LAS unsigned*)(lds + (bufoff) + ldsw + _i * 8192), 16, 0, 0); } while (0)
#define PG8_D_voffA dA
#define PG8_D_voffB dB
#define PG8_LDA(dst, b, h) do { _Pragma("unroll") for (int m = 0; m < 4; ++m) _Pragma("unroll") for (int k = 0; k < 2; ++k) dst[m][k] = *(const LAS bf16x8*)(lds + PG8_SA(b, h) + aoff + m * 2048 + k * 1024); } while (0)
#define PG8_LDB(dst, b, h) do { _Pragma("unroll") for (int n = 0; n < 2; ++n) _Pragma("unroll") for (int k = 0; k < 2; ++k) dst[n][k] = *(const LAS bf16x8*)(lds + PG8_SB(b, h) + boff + n * 2048 + k * 1024); } while (0)
#define PG8_MMA(ai, bj, At, Bt) do { __builtin_amdgcn_s_setprio(1); _Pragma("unroll") for (int m = 0; m < 4; ++m) _Pragma("unroll") for (int n = 0; n < 2; ++n) _Pragma("unroll") for (int k = 0; k < 2; ++k) \
        acc[ai][bj][m][n] = __builtin_amdgcn_mfma_f32_16x16x32_bf16(Bt[n][k], At[m][k], acc[ai][bj][m][n], 0, 0, 0); __builtin_amdgcn_s_setprio(0); } while (0)
#define PG8_WAIT_V(n) asm volatile("s_waitcnt vmcnt(" #n ")" ::: "memory")
#define PG8_WAIT_L(n) asm volatile("s_waitcnt lgkmcnt(" #n ")" ::: "memory")
#define PG8_BAR __builtin_amdgcn_s_barrier()
#define PG8_SCHED __builtin_amdgcn_sched_barrier(0)
    Unit cur, nxt; int ui = 0;
    if (!S.next(0, cur)) return;
    cur.pm = __builtin_amdgcn_readfirstlane(cur.pm); cur.pn = __builtin_amdgcn_readfirstlane(cur.pn);
    f32x4 acc[2][2][4][2];
#pragma unroll
    for (int a = 0; a < 2; ++a)
#pragma unroll
        for (int b = 0; b < 2; ++b)
#pragma unroll
            for (int m = 0; m < 4; ++m)
#pragma unroll
                for (int n = 0; n < 2; ++n) acc[a][b][m][n] = (f32x4){0.f, 0.f, 0.f, 0.f};
    bf16x8 At[4][2], B0[2][2], B1[2][2];
    const char* cA = (const char*)g.A + (size_t)cur.pm * tstepA;
    const char* cB = (const char*)g.Bt + (size_t)(cur.pm >> g.gm) * g.gstrideB + (size_t)cur.pn * tstepB;
    PG8_STAGE(PG8_SB(0, 0), cB, voffB); PG8_STAGE(PG8_SA(0, 0), cA, voffA); PG8_STAGE(PG8_SB(0, 1), cB + hstepB, voffB); PG8_STAGE(PG8_SA(0, 1), cA + hstepA, voffA);
    if (wr == 1) PG8_BAR;
    PG8_WAIT_V(4); PG8_BAR;
    PG8_STAGE(PG8_SB(1, 0), cB + kstep, voffB); PG8_STAGE(PG8_SA(1, 0), cA + kstep, voffA); PG8_STAGE(PG8_SB(1, 1), cB + hstepB + kstep, voffB);
    PG8_WAIT_V(6); PG8_BAR;
    for (;;) {
        const bool has_next = S.next(ui + 1, nxt);
        nxt.pm = __builtin_amdgcn_readfirstlane(nxt.pm); nxt.pn = __builtin_amdgcn_readfirstlane(nxt.pn);
        const char* nA = has_next ? (const char*)g.A + (size_t)nxt.pm * tstepA : cA;
        const char* nB = has_next ? (const char*)g.Bt + (size_t)(nxt.pm >> g.gm) * g.gstrideB + (size_t)nxt.pn * tstepB : cB;
        for (int t = 0; t < nt; t += 2) {
            const bool last = (t == nt - 2);
            const char* a1 = cA + (size_t)(t + 1) * kstep;
            const char* a2 = last ? nA : cA + (size_t)(t + 2) * kstep; const char* b2 = last ? nB : cB + (size_t)(t + 2) * kstep;
            const char* a3 = a2 + kstep; const char* b3 = b2 + kstep;
            PG8_LDB(B0, 0, 0); PG8_SCHED; PG8_LDA(At, 0, 0); PG8_STAGE(PG8_SA(1, 1), a1 + hstepA, voffA);
            PG8_WAIT_L(8); PG8_BAR; PG8_WAIT_L(0); PG8_MMA(0, 0, At, B0); PG8_BAR; PG8_SCHED;
            PG8_LDB(B1, 0, 1); PG8_STAGE(PG8_SB(0, 0), b2, voffB);
            PG8_BAR; PG8_WAIT_L(0); PG8_MMA(0, 1, At, B1); PG8_BAR;
            PG8_LDA(At, 0, 1); PG8_STAGE(PG8_SA(0, 0), a2, voffA);
            PG8_BAR; PG8_WAIT_L(0); PG8_MMA(1, 0, At, B0); PG8_BAR; PG8_SCHED;
            PG8_STAGE(PG8_SB(0, 1), b2 + hstepB, voffB);
            PG8_WAIT_V(6); PG8_BAR; PG8_MMA(1, 1, At, B1); PG8_BAR;
            PG8_LDB(B0, 1, 0); PG8_SCHED; PG8_LDA(At, 1, 0); PG8_STAGE(PG8_SA(0, 1), a2 + hstepA, voffA);
            PG8_WAIT_L(8); PG8_BAR; PG8_WAIT_L(0); PG8_MMA(0, 0, At, B0); PG8_BAR; PG8_SCHED;
            PG8_LDB(B1, 1, 1); PG8_STAGE(PG8_SB(1, 0), b3, voffB);
            PG8_BAR; PG8_WAIT_L(0); PG8_MMA(0, 1, At, B1); PG8_BAR;
            PG8_LDA(At, 1, 1); PG8_STAGE(PG8_SA(1, 0), a3, voffA);
            PG8_BAR; PG8_WAIT_L(0); PG8_MMA(1, 0, At, B0); PG8_BAR; PG8_SCHED;
            PG8_STAGE(PG8_SB(1, 1), b3 + hstepB, voffB);
            PG8_WAIT_V(6); PG8_BAR; PG8_MMA(1, 1, At, B1); PG8_BAR;
        }
        { const int l2 = otid() & 63; E(acc, cur, wr, wc, l2 & 15, l2 >> 4); }
        if (!has_next) break;
#pragma unroll
        for (int a = 0; a < 2; ++a)
#pragma unroll
            for (int b = 0; b < 2; ++b)
#pragma unroll
                for (int m = 0; m < 4; ++m)
#pragma unroll
                    for (int n = 0; n < 2; ++n) acc[a][b][m][n] = (f32x4){0.f, 0.f, 0.f, 0.f};
        cur = nxt; cA = nA; cB = nB; ++ui;
    }
    PG8_WAIT_V(0);
    if (wr == 0) PG8_BAR;
    PG8_BAR;
#undef PG8_SA
#undef PG8_SB
#undef PG8_STAGE
#undef PG8_D_voffA
#undef PG8_D_voffB
#undef PG8_LDA
#undef PG8_LDB
#undef PG8_MMA
#undef PG8_WAIT_V
#undef PG8_WAIT_L
#undef PG8_BAR
#undef PG8_SCHED
}
}
using pg8::Unit;

#define EPI_ROW(ai, m) (u.pm * 256 + (ai) * 128 + wr * 64 + (m) * 16 + fr)
typedef const f32x4 (&AccRef)[2][2][4][2];
__device__ __forceinline__ u32x4 pack8(f32x4 v0, f32x4 v1) { u32x4 w; w.x = cvt_pk_bf16(v0[0], v0[1]); w.y = cvt_pk_bf16(v0[2], v0[3]); w.z = cvt_pk_bf16(v1[0], v1[1]); w.w = cvt_pk_bf16(v1[2], v1[3]); return w; }

struct EpiIn {
    static constexpr bool PERM = true;
    bf16_t *R; const float* rstd1; const float* bias1;
    __device__ __forceinline__ void operator()(AccRef acc, const Unit& u, int wr, int wc, int fr, int fq) const {
        const int pn = u.pn, b = (u.pm * 256) >> 13;
        f32x4 bv[2][2];
#pragma unroll
        for (int bj = 0; bj < 2; ++bj)
#pragma unroll
            for (int n = 0; n < 2; ++n) bv[bj][n] = *(const f32x4*)(bias1 + b * DIN + pn * 256 + bj * 128 + wc * 32 + 8 * fq + 4 * n);
#pragma unroll
        for (int ai = 0; ai < 2; ++ai)
#pragma unroll
            for (int m = 0; m < 4; ++m) {
                const int row = EPI_ROW(ai, m); const float rs = rstd1[row];
#pragma unroll
                for (int bj = 0; bj < 2; ++bj) {
                    const u32x4 w = pack8(acc[ai][bj][m][0] * rs + bv[bj][0], acc[ai][bj][m][1] * rs + bv[bj][1]);
                    const int cl = bj * 128 + wc * 32 + 8 * fq;
                    size_t eo;
                    if (pn < 6) eo = (size_t)(pn >> 1) * (16u << 20) + (size_t)row * 512 + (pn & 1) * 256 + cl;
                    else if (pn == 6) eo = (WS_LO - WS_R) / 2 + (size_t)row * 256 + cl;
                    else { const int cu = (pn - 7) * 256 + cl, g = cu >> 4, ch = cu & 15; eo = (WS_USIN - WS_R) / 2 + ((size_t)(g * 2048 + (row >> 4)) * 384 + (row & 15) * 16 + ch); }
                    *(u32x4*)(R + eo) = w;
                }
            }
    }
};
struct EpiLora {
    static constexpr bool PERM = true;
    bf16_t* W; bf16_t* AA; bf16_t* G; const float* w0; const float* a0; int pn_off;
    static __device__ __forceinline__ float decay_of(float x) { return 0.6065306597126334f * sigmoidf_(x); }
    __device__ __forceinline__ void operator()(AccRef acc, const Unit& u, int wr, int wc, int fr, int fq) const {
        const int pnx = u.pn + pn_off, type = pnx >> 1, cb = (pnx & 1) * 256 + wc * 32 + 8 * fq;
        if (type == 0) {
#pragma unroll
            for (int bj = 0; bj < 2; ++bj) {
                const int c8 = cb + bj * 128; const f32x4 b0 = *(const f32x4*)(w0 + c8), b1 = *(const f32x4*)(w0 + c8 + 4);
#pragma unroll
                for (int ai = 0; ai < 2; ++ai)
#pragma unroll
                    for (int m = 0; m < 4; ++m) {
                        const int row = EPI_ROW(ai, m); f32x4 v0 = acc[ai][bj][m][0] + b0, v1 = acc[ai][bj][m][1] + b1;
#pragma unroll
                        for (int j = 0; j < 4; ++j) { v0[j] = decay_of(v0[j]); v1[j] = decay_of(v1[j]); }
                        *(u32x4*)(W + (size_t)row * 512 + c8) = pack8(v0, v1);
                    }
            }
        } else if (type == 1) {
#pragma unroll
            for (int bj = 0; bj < 2; ++bj) {
                const int c8 = cb + bj * 128; const f32x4 b0 = *(const f32x4*)(a0 + c8), b1 = *(const f32x4*)(a0 + c8 + 4);
#pragma unroll
                for (int ai = 0; ai < 2; ++ai)
#pragma unroll
                    for (int m = 0; m < 4; ++m) {
                        const int row = EPI_ROW(ai, m); f32x4 v0 = acc[ai][bj][m][0] + b0, v1 = acc[ai][bj][m][1] + b1;
#pragma unroll
                        for (int j = 0; j < 4; ++j) { v0[j] = sigmoidf_(v0[j]); v1[j] = sigmoidf_(v1[j]); }
                        *(u32x4*)(AA + (size_t)row * 512 + c8) = pack8(v0, v1);
                    }
            }
        } else {
#pragma unroll
            for (int bj = 0; bj < 2; ++bj)
#pragma unroll
                for (int ai = 0; ai < 2; ++ai)
#pragma unroll
                    for (int m = 0; m < 4; ++m) {
                        const int row = EPI_ROW(ai, m);
                        *(u32x4*)(G + (size_t)row * 512 + cb + bj * 128) = pack8(acc[ai][bj][m][0], acc[ai][bj][m][1]);
                    }
        }
    }
};
struct EpiS1 {
    static constexpr bool PERM = true;
    bf16_t* SLOC;
    __device__ __forceinline__ void operator()(AccRef acc, const Unit& u, int wr, int wc, int fr, int fq) const {
#pragma unroll
        for (int ai = 0; ai < 2; ++ai)
#pragma unroll
            for (int m = 0; m < 4; ++m) {
                const int row = EPI_ROW(ai, m);
                *(u32x4*)(SLOC + (size_t)row * 128 + wc * 32 + 8 * fq) = pack8(acc[ai][0][m][0], acc[ai][0][m][1]);
            }
    }
};
struct EpiS2 {
    static constexpr bool PERM = true;
    const bf16_t* USIN; bf16_t* ZZ; const float* dskip;
    __device__ __forceinline__ void operator()(AccRef acc, const Unit& u, int wr, int wc, int fr, int fq) const {
#pragma unroll
        for (int ai = 0; ai < 2; ++ai)
#pragma unroll
            for (int m = 0; m < 4; ++m) {
                const int row = EPI_ROW(ai, m), g = row >> 11, rig = row & 2047;
#pragma unroll
                for (int bj = 0; bj < 2; ++bj) {
                    const int col = bj * 128 + wc * 32 + 8 * fq, t = col >> 4, c = col & 15;
                    const u32x4 uu = *(const u32x4*)(USIN + (size_t)row * 384 + col);
                    const f32x4 d0 = *(const f32x4*)(dskip + g * 16 + c), d1 = *(const f32x4*)(dskip + g * 16 + c + 4);
                    f32x4 v0 = acc[ai][bj][m][0], v1 = acc[ai][bj][m][1];
                    v0[0] += d0[0] * bflo(uu.x); v0[1] += d0[1] * bfhi(uu.x); v0[2] += d0[2] * bflo(uu.y); v0[3] += d0[3] * bfhi(uu.y);
                    v1[0] += d1[0] * bflo(uu.z); v1[1] += d1[1] * bfhi(uu.z); v1[2] += d1[2] * bflo(uu.w); v1[3] += d1[3] * bfhi(uu.w);
#pragma unroll
                    for (int j = 0; j < 4; ++j) { v0[j] = gelu_tanh(v0[j]); v1[j] = gelu_tanh(v1[j]); }
                    *(u32x4*)(ZZ + (size_t)(rig * 16 + t) * 512 + g * 16 + c) = pack8(v0, v1);
                }
            }
    }
};
struct EpiGlu {
    static constexpr bool PERM = true;
    const bf16_t* ZZ; bf16_t* GLUO; const float* bglu; float* rss;
    __device__ __forceinline__ void operator()(AccRef acc, const Unit& u, int wr, int wc, int fr, int fq) const {
#pragma unroll
        for (int ai = 0; ai < 2; ++ai)
#pragma unroll
            for (int m = 0; m < 4; ++m) {
                const int row = EPI_ROW(ai, m); float ss = 0.f;
#pragma unroll
                for (int bj = 0; bj < 2; ++bj) {
                    const int col = u.pn * 256 + bj * 128 + wc * 32 + 8 * fq;
                    const u32x4 zz = *(const u32x4*)(ZZ + (size_t)row * 512 + col);
                    const f32x4 b0 = *(const f32x4*)(bglu + col), b1 = *(const f32x4*)(bglu + col + 4);
                    f32x4 v0 = acc[ai][bj][m][0] + b0, v1 = acc[ai][bj][m][1] + b1;
                    v0[0] = bflo(zz.x) * sigmoidf_(v0[0]); v0[1] = bfhi(zz.x) * sigmoidf_(v0[1]); v0[2] = bflo(zz.y) * sigmoidf_(v0[2]); v0[3] = bfhi(zz.y) * sigmoidf_(v0[3]);
                    v1[0] = bflo(zz.z) * sigmoidf_(v1[0]); v1[1] = bfhi(zz.z) * sigmoidf_(v1[1]); v1[2] = bflo(zz.w) * sigmoidf_(v1[2]); v1[3] = bfhi(zz.w) * sigmoidf_(v1[3]);
#pragma unroll
                    for (int j = 0; j < 4; ++j) ss += v0[j] * v0[j] + v1[j] * v1[j];
                    *(u32x4*)(GLUO + (size_t)row * 512 + col) = pack8(v0, v1);
                }
                ss += __shfl_xor(ss, 16); ss += __shfl_xor(ss, 32);
                if (fq == 0) rss[(size_t)row * 8 + u.pn * 4 + wc] = ss;
            }
    }
};
struct EpiOut {
    static constexpr bool PERM = true;
    const float* x; bf16_t* X1; bf16_t* A2; const float* ada; float* rss;
    __device__ __forceinline__ void operator()(AccRef acc, const Unit& u, int wr, int wc, int fr, int fq) const {
        const int b = (u.pm * 256) >> 13;
        const float* gm = ada + b * 6144 + 2048; const float* scf = ada + b * 6144 + 4096;
        f32x4 gv[2][2], sv[2][2];
#pragma unroll
        for (int bj = 0; bj < 2; ++bj)
#pragma unroll
            for (int n = 0; n < 2; ++n) { const int col = u.pn * 256 + bj * 128 + wc * 32 + 8 * fq + 4 * n; gv[bj][n] = *(const f32x4*)(gm + col); sv[bj][n] = *(const f32x4*)(scf + col) + 1.0f; }
#pragma unroll
        for (int ai = 0; ai < 2; ++ai)
#pragma unroll
            for (int m = 0; m < 4; ++m) {
                const int row = EPI_ROW(ai, m); float ss = 0.f;
#pragma unroll
                for (int bj = 0; bj < 2; ++bj) {
                    const size_t off = (size_t)row * 1024 + u.pn * 256 + bj * 128 + wc * 32 + 8 * fq;
                    const f32x4 x0 = ldnt((const f32x4*)(x + off)) + gv[bj][0] * acc[ai][bj][m][0];
                    const f32x4 x1 = ldnt((const f32x4*)(x + off + 4)) + gv[bj][1] * acc[ai][bj][m][1];
                    *(u32x4*)(X1 + off) = pack8(x0, x1);
                    ss += (x0[0] * x0[0] + x0[1] * x0[1] + x0[2] * x0[2] + x0[3] * x0[3]) + (x1[0] * x1[0] + x1[1] * x1[1] + x1[2] * x1[2] + x1[3] * x1[3]);
                    *(u32x4*)(A2 + off) = pack8(x0 * sv[bj][0], x1 * sv[bj][1]);
                }
                ss += __shfl_xor(ss, 16); ss += __shfl_xor(ss, 32);
                if (fq == 0) rss[(size_t)row * 16 + u.pn * 4 + wc] = ss;
            }
    }
};
struct EpiGU {
    static constexpr bool PERM = true;
    bf16_t* HMID; const float* rss2; const float* bias2;
    __device__ __forceinline__ void operator()(AccRef acc, const Unit& u, int wr, int wc, int fr, int fq) const {
        const int b = (u.pm * 256) >> 13;
        f32x4 bv[2][2];
#pragma unroll
        for (int bj = 0; bj < 2; ++bj)
#pragma unroll
            for (int n = 0; n < 2; ++n) bv[bj][n] = *(const f32x4*)(bias2 + b * 5632 + u.pn * 256 + bj * 128 + wc * 32 + 8 * fq + 4 * n);
#pragma unroll
        for (int ai = 0; ai < 2; ++ai)
#pragma unroll
            for (int m = 0; m < 4; ++m) {
                const int row = EPI_ROW(ai, m); const f32x4* rp = (const f32x4*)(rss2 + (size_t)row * 16); const f32x4 q4 = (rp[0] + rp[1]) + (rp[2] + rp[3]); const float rs = rsqrtf(((q4[0] + q4[1]) + (q4[2] + q4[3])) * (1.0f / 1024.0f) + 1e-6f);
                f32x4 h0, h1;
#pragma unroll
                for (int j = 0; j < 4; ++j) {
                    const float g0 = acc[ai][0][m][0][j] * rs + bv[0][0][j], u0 = acc[ai][1][m][0][j] * rs + bv[1][0][j];
                    const float g1 = acc[ai][0][m][1][j] * rs + bv[0][1][j], u1 = acc[ai][1][m][1][j] * rs + bv[1][1][j];
                    h0[j] = siluf_(g0) * u0; h1[j] = siluf_(g1) * u1;
                }
                *(u32x4*)(HMID + (size_t)row * DFF + u.pn * 128 + wc * 32 + 8 * fq) = pack8(h0, h1);
            }
    }
};
struct EpiDown {
    static constexpr bool PERM = true;
    const bf16_t* X1; bf16_t* out; const float* ada; float* rss;
    __device__ __forceinline__ void operator()(AccRef acc, const Unit& u, int wr, int wc, int fr, int fq) const {
        const int b = (u.pm * 256) >> 13;
        const float* gf = ada + b * 6144 + 5120;
        f32x4 gv[2][2];
#pragma unroll
        for (int bj = 0; bj < 2; ++bj)
#pragma unroll
            for (int n = 0; n < 2; ++n) gv[bj][n] = *(const f32x4*)(gf + u.pn * 256 + bj * 128 + wc * 32 + 8 * fq + 4 * n);
#pragma unroll
        for (int ai = 0; ai < 2; ++ai)
#pragma unroll
            for (int m = 0; m < 4; ++m) {
                const int row = EPI_ROW(ai, m); float ss = 0.f;
#pragma unroll
                for (int bj = 0; bj < 2; ++bj) {
                    const size_t off = (size_t)row * 1024 + u.pn * 256 + bj * 128 + wc * 32 + 8 * fq;
                    const u32x4 xb = ldnt((const u32x4*)(X1 + off));
                    const f32x4 x0 = (f32x4){bflo(xb.x), bfhi(xb.x), bflo(xb.y), bfhi(xb.y)} + gv[bj][0] * acc[ai][bj][m][0];
                    const f32x4 x1 = (f32x4){bflo(xb.z), bfhi(xb.z), bflo(xb.w), bfhi(xb.w)} + gv[bj][1] * acc[ai][bj][m][1];
                    *(u32x4*)(out + off) = pack8(x0, x1);
                    ss += (x0[0] * x0[0] + x0[1] * x0[1] + x0[2] * x0[2] + x0[3] * x0[3]) + (x1[0] * x1[0] + x1[1] * x1[1] + x1[2] * x1[2] + x1[3] * x1[3]);
                }
                ss += __shfl_xor(ss, 16); ss += __shfl_xor(ss, 32);
                if (fq == 0) rss[(size_t)row * 16 + u.pn * 4 + wc] = ss;
            }
    }
};

enum { I_X = 0, I_C, I_WADA, I_BADA, I_WIN, I_MU, I_W0, I_W2, I_A0, I_A2, I_G2, I_KK, I_KA, I_RK, I_LNW, I_LNB, I_SARE, I_SAIM, I_SLDT,
       I_SBRE, I_SBIM, I_SCRE, I_SCIM, I_SD, I_WGLU, I_BGLU, I_SGAIN, I_WOUT, I_FG, I_FU, I_FD, I_FGAIN };

template <class Map>
__device__ __forceinline__ void transpose_cvt(bf16_t* dst, const float* src, int Nd, int Kd, int ld, Map map, int gtid, int gthreads) {
    const int items = Nd * (Kd / 8);
    for (int it0 = gtid; it0 < items; it0 += 2 * gthreads) {
        float v[2][8];
#pragma unroll
        for (int u = 0; u < 2; ++u) { const int it = it0 + u * gthreads; if (it < items) { const int n = it % Nd, k8 = it / Nd; const int sc = map(n);
#pragma unroll
            for (int j = 0; j < 8; ++j) v[u][j] = src[(size_t)(k8 * 8 + j) * ld + sc]; } }
#pragma unroll
        for (int u = 0; u < 2; ++u) { const int it = it0 + u * gthreads; if (it < items) { const int n = it % Nd, k8 = it / Nd;
            u32x4 w; w.x = cvt_pk_bf16(v[u][0], v[u][1]); w.y = cvt_pk_bf16(v[u][2], v[u][3]); w.z = cvt_pk_bf16(v[u][4], v[u][5]); w.w = cvt_pk_bf16(v[u][6], v[u][7]);
            *(u32x4*)(dst + (size_t)n * Kd + k8 * 8) = w; } }
    }
}

__device__ __forceinline__ void s5_mats(const Params& p, int g, int part, LAS unsigned char* lds) {
    LAS float* ap_re = (LAS float*)lds;
    LAS float* ap_im = ap_re + 17 * 64;
    LAS float* bb_re = ap_im + 17 * 64;
    LAS float* bb_im = bb_re + 1024;
    LAS float* c_re = bb_im + 1024;
    LAS float* c_im = c_re + 1024;
    LAS float* ktab = c_im + 1024;
    const int tid = otid();
    const float dt = expf(p.in[I_SLDT][g]);
    const float* are_p = p.in[I_SARE] + g * 64; const float* aim_p = p.in[I_SAIM] + g * 64;
    for (int i = tid; i < 17 * 64; i += 512) { const int tau = i >> 6, pp = i & 63; const float mag = expf((float)tau * dt * are_p[pp]), ang = (float)tau * dt * aim_p[pp]; ap_re[i] = mag * cosf(ang); ap_im[i] = mag * sinf(ang); }
    for (int i = tid; i < 1024; i += 512) {
        const int pp = i >> 4;
        const float are = are_p[pp], aim = aim_p[pp], mag = expf(dt * are), abr = mag * cosf(dt * aim), abi = mag * sinf(dt * aim), den = are * are + aim * aim;
        const float pr = abr - 1.0f, q = abi, cre = (pr * are + q * aim) / den, cim = (q * are - pr * aim) / den;
        const float bre = p.in[I_SBRE][(size_t)g * 1024 + i], bim = p.in[I_SBIM][(size_t)g * 1024 + i];
        bb_re[i] = cre * bre - cim * bim; bb_im[i] = cre * bim + cim * bre;
        c_re[i] = p.in[I_SCRE][(size_t)g * 1024 + i]; c_im[i] = p.in[I_SCIM][(size_t)g * 1024 + i];
    }
    __syncthreads();
    {   const int i = tid, tau = i >> 5, cl = (i >> 4) & 1, cc = 2 * part + cl, c2 = i & 15; float s = 0.f;
        for (int pp = 0; pp < 64; ++pp) {
            const float cr = c_re[cc * 64 + pp], ci = c_im[cc * 64 + pp], ar = ap_re[tau * 64 + pp], ai = ap_im[tau * 64 + pp];
            const float xr = cr * ar - ci * ai, xi = cr * ai + ci * ar;
            s += xr * bb_re[pp * 16 + c2] - xi * bb_im[pp * 16 + c2];
        }
        ktab[i] = s; }
    __syncthreads();
    bf16_t* TV = (bf16_t*)(p.ws + WS_S5TV) + (size_t)g * 256 * 384;
    for (int i = tid; i < 32 * 384; i += 512) {
        const int rr = i / 384, kk = i % 384, t = rr >> 1, cl = rr & 1, cc = 2 * part + cl, n = t * 16 + cc; float val;
        if (kk < 256) { const int sx = kk >> 4, c2 = kk & 15; val = (sx <= t) ? ktab[(t - sx) * 32 + cl * 16 + c2] : 0.f; }
        else { const int q = kk - 256, pp = q & 63, tau = t + 1; const float cr = c_re[cc * 64 + pp], ci = c_im[cc * 64 + pp], ar = ap_re[tau * 64 + pp], ai = ap_im[tau * 64 + pp];
            val = (q < 64) ? (cr * ar - ci * ai) : -(cr * ai + ci * ar); }
        TV[(size_t)n * 384 + kk] = f2bf(val);
    }
    bf16_t* WG = (bf16_t*)(p.ws + WS_S5W) + (size_t)g * 256 * 256;
    for (int i = tid; i < 32 * 256; i += 512) {
        const int rr = i >> 8, kk = i & 255, sx = kk >> 4, c2 = kk & 15, n = (rr < 16) ? (16 * part + rr) : (128 + 16 * part + (rr - 16)); float val = 0.f;
        if (n < 128) { const int pp = n & 63, tau = 15 - sx; const float ar = ap_re[tau * 64 + pp], ai = ap_im[tau * 64 + pp], br = bb_re[pp * 16 + c2], bi = bb_im[pp * 16 + c2];
            val = (n < 64) ? (ar * br - ai * bi) : (ar * bi + ai * br); }
        WG[(size_t)n * 256 + kk] = f2bf(val);
    }
    __syncthreads();
}

__device__ __forceinline__ void phase0(const Params& p, LAS unsigned char* lds, bool do_ada) {
    const int tid = otid(), nblk = gridDim.x, blk = blockIdx.x;
    unsigned char* ws = p.ws;
    float* ada = (float*)(ws + WS_SMALL + SM_ADA);
    const int nada = (nblk >= 192) ? 96 : (nblk > 1 ? nblk / 2 : 1);
    if (blk < nada) {
        if (do_ada) {
            const int lane = tid & 63, wv = tid >> 6; LAS float* part = (LAS float*)lds;
            LAS float* sil = part + 2048;
            for (int i = tid; i < 4096; i += 512) sil[i] = siluf_(p.in[I_C][i]);
            __syncthreads();
            for (int cbk = blk; cbk < 96; cbk += nada) {
                const int col = cbk * 64 + lane; float a0 = 0.f, a1 = 0.f, a2 = 0.f, a3 = 0.f;
                const float* wp = p.in[I_WADA] + (size_t)(wv * 128) * 6144 + col; const LAS float* sp = sil + wv * 128;
                for (int k0 = 0; k0 < 128; k0 += 16) {
                    float w[16];
#pragma unroll
                    for (int j = 0; j < 16; ++j) w[j] = wp[(size_t)(k0 + j) * 6144];
#pragma unroll
                    for (int j = 0; j < 16; ++j) { a0 += sp[k0 + j] * w[j]; a1 += sp[1024 + k0 + j] * w[j]; a2 += sp[2048 + k0 + j] * w[j]; a3 += sp[3072 + k0 + j] * w[j]; }
                }
                __syncthreads();
                part[(wv * 4 + 0) * 64 + lane] = a0; part[(wv * 4 + 1) * 64 + lane] = a1; part[(wv * 4 + 2) * 64 + lane] = a2; part[(wv * 4 + 3) * 64 + lane] = a3;
                __syncthreads();
                if (tid < 256) { const int bb = tid >> 6; float sacc = p.in[I_BADA][col];
#pragma unroll
                    for (int w8 = 0; w8 < 8; ++w8) sacc += part[(w8 * 4 + bb) * 64 + lane];
                    ada[bb * 6144 + col] = sacc; }
            }
            __syncthreads();
        }
        if (nblk > nada) return;
    }
    const int tb_ = (nblk > nada) ? blk - nada : blk, tn_ = (nblk > nada) ? nblk - nada : nblk;
    const int gtid = tb_ * 512 + tid, gth = tn_ * 512;
    transpose_cvt((bf16_t*)(ws + WS_WIN_T), p.in[I_WIN], 2304, 1024, 2304, [](int n) { return n; }, gtid, gth);
}

__device__ __forceinline__ void late_weights(const Params& p, int gtid, int gth) {
    unsigned char* ws = p.ws;
    transpose_cvt((bf16_t*)(ws + WS_WOUT_T), p.in[I_WOUT], 1024, 1024, 1024, [](int n) { return n; }, gtid, gth);
    transpose_cvt((bf16_t*)(ws + WS_DOWN_T), p.in[I_FD], 1024, 2816, 1024, [](int n) { return n; }, gtid, gth);
    {
        bf16_t* dst = (bf16_t*)(ws + WS_GU_T);
        const int items = 5632 * 128;
        for (int it0 = gtid; it0 < items; it0 += 2 * gth) {
            float v[2][8];
#pragma unroll
            for (int u = 0; u < 2; ++u) { const int it = it0 + u * gth; if (it < items) { const int n = it % 5632, k8 = it / 5632, pn = n >> 8, wi = n & 255; const float* src = (wi < 128) ? p.in[I_FG] : p.in[I_FU]; const int sc = pn * 128 + (wi & 127);
#pragma unroll
                for (int j = 0; j < 8; ++j) v[u][j] = src[(size_t)(k8 * 8 + j) * DFF + sc]; } }
#pragma unroll
            for (int u = 0; u < 2; ++u) { const int it = it0 + u * gth; if (it < items) { const int n = it % 5632, k8 = it / 5632;
                u32x4 w; w.x = cvt_pk_bf16(v[u][0], v[u][1]); w.y = cvt_pk_bf16(v[u][2], v[u][3]); w.z = cvt_pk_bf16(v[u][4], v[u][5]); w.w = cvt_pk_bf16(v[u][6], v[u][7]);
                *(u32x4*)(dst + (size_t)n * 1024 + k8 * 8) = w; } }
        }
    }
}
__device__ __forceinline__ void late_bias2(const Params& p, int gw, int nw) {
    unsigned char* ws = p.ws; const int lane = otid() & 63;
    const float* ada = (const float*)(ws + WS_SMALL + SM_ADA); float* bias2 = (float*)(ws + WS_SMALL + SM_BIAS2);
    for (int n = gw; n < 5632; n += nw) {
        const bf16_t* wrow = (const bf16_t*)(ws + WS_GU_T) + (size_t)n * 1024;
        float a[4] = {0.f, 0.f, 0.f, 0.f};
#pragma unroll
        for (int i = 0; i < 2; ++i) {
            const int k0 = i * 512 + lane * 8; const u32x4 wv = *(const u32x4*)(wrow + k0);
            float wf[8]; unpack8(wv, wf);
#pragma unroll
            for (int b = 0; b < 4; ++b) { const float* sh = ada + b * 6144 + 3072 + k0;
#pragma unroll
                for (int j = 0; j < 8; ++j) a[b] += sh[j] * wf[j]; }
        }
#pragma unroll
        for (int b = 0; b < 4; ++b) a[b] = wave_sum(a[b]);
        if (lane == 0) {
#pragma unroll
            for (int b = 0; b < 4; ++b) bias2[b * 5632 + n] = a[b]; }
    }
}

__device__ __forceinline__ void deferred_setup(const Params& p, LAS unsigned char* lds, int bi, int nb) {
    unsigned char* ws = p.ws; const int tid = otid();
    for (int u = bi; u < NG * 8; u += nb) s5_mats(p, u >> 3, u & 7, lds);
    const int gtid = bi * 512 + tid, gth = nb * 512;
    transpose_cvt((bf16_t*)(ws + WS_WGLU_T), p.in[I_WGLU], 512, 512, 512, [](int n) { return n; }, gtid, gth);
    {
        bf16_t* dst = (bf16_t*)(ws + WS_LORA_T);
        const int items = 1536 * 32;
        for (int it = gtid; it < items; it += gth) {
            const int n = it % 1536, k8 = it / 1536, k0 = k8 * 8; float v[8];
#pragma unroll
            for (int j = 0; j < 8; ++j) { const int k = k0 + j; float x = 0.f;
                if (n < 512) { if (k < 64) x = p.in[I_W2][(size_t)k * 512 + n]; }
                else if (n < 1024) { if (k >= 64 && k < 128) x = p.in[I_A2][(size_t)(k - 64) * 512 + (n - 512)]; }
                else { if (k >= 128) x = p.in[I_G2][(size_t)(k - 128) * 512 + (n - 1024)]; }
                v[j] = x; }
            u32x4 w; w.x = cvt_pk_bf16(v[0], v[1]); w.y = cvt_pk_bf16(v[2], v[3]); w.z = cvt_pk_bf16(v[4], v[5]); w.w = cvt_pk_bf16(v[6], v[7]);
            *(u32x4*)(dst + (size_t)n * 256 + k0) = w;
        }
    }
}

__device__ __forceinline__ void phase1(const Params& p) {
    const int tid = otid(), lane = tid & 63, gw = blockIdx.x * 8 + (tid >> 6), nw = gridDim.x * 8;
    unsigned char* ws = p.ws;
    const float* ada = (const float*)(ws + WS_SMALL + SM_ADA);
    bf16_t* A1 = (bf16_t*)(ws + WS_A1); float* rstd1 = (float*)(ws + WS_SMALL + SM_RSTD1);
    for (int row0 = gw * 4; row0 < NT; row0 += nw * 4) {
        const int b = row0 >> 13; const float* sc = ada + b * 6144 + 1024;
        f32x4 xv[4][4];
#pragma unroll
        for (int r = 0; r < 4; ++r)
#pragma unroll
            for (int i = 0; i < 4; ++i) xv[r][i] = ldnt((const f32x4*)(p.in[I_X] + (size_t)(row0 + r) * 1024 + i * 256 + lane * 4));
        f32x4 sv[4];
#pragma unroll
        for (int i = 0; i < 4; ++i) sv[i] = *(const f32x4*)(sc + i * 256 + lane * 4) + 1.0f;
#pragma unroll
        for (int r = 0; r < 4; ++r) {
            float ss = 0.f;
#pragma unroll
            for (int i = 0; i < 4; ++i) ss += xv[r][i][0] * xv[r][i][0] + xv[r][i][1] * xv[r][i][1] + xv[r][i][2] * xv[r][i][2] + xv[r][i][3] * xv[r][i][3];
            ss = wave_sum(ss);
            if (lane == 0) rstd1[row0 + r] = rsqrtf(ss * (1.0f / 1024.0f) + 1e-6f);
#pragma unroll
            for (int i = 0; i < 4; ++i) { const f32x4 a = xv[r][i] * sv[i]; u32x2 w; w.x = cvt_pk_bf16(a[0], a[1]); w.y = cvt_pk_bf16(a[2], a[3]);
                *(u32x2*)(A1 + (size_t)(row0 + r) * 1024 + i * 256 + lane * 4) = w; }
        }
    }
    float* bias1 = (float*)(ws + WS_SMALL + SM_BIAS1); float* bias2 = (float*)(ws + WS_SMALL + SM_BIAS2);
    for (int it = gw; it < 2304; it += nw) {
        const bool first = it < 2304; const int n = first ? it : it - 2304;
        const bf16_t* wrow = first ? (const bf16_t*)(ws + WS_WIN_T) + (size_t)n * 1024 : (const bf16_t*)(ws + WS_GU_T) + (size_t)n * 1024;
        const int shoff = first ? 0 : 3072;
        float a[4] = {0.f, 0.f, 0.f, 0.f};
#pragma unroll
        for (int i = 0; i < 2; ++i) {
            const int k0 = i * 512 + lane * 8; const u32x4 wv = *(const u32x4*)(wrow + k0);
            const float wf[8] = {bflo(wv.x), bfhi(wv.x), bflo(wv.y), bfhi(wv.y), bflo(wv.z), bfhi(wv.z), bflo(wv.w), bfhi(wv.w)};
#pragma unroll
            for (int b = 0; b < 4; ++b) { const float* sh = ada + b * 6144 + shoff + k0;
#pragma unroll
                for (int j = 0; j < 8; ++j) a[b] += sh[j] * wf[j]; }
        }
#pragma unroll
        for (int b = 0; b < 4; ++b) a[b] = wave_sum(a[b]);
        if (lane == 0) { float* dst = first ? bias1 : bias2; const int ld = first ? 2304 : 5632;
#pragma unroll
            for (int b = 0; b < 4; ++b) dst[b * ld + n] = a[b]; }
    }
}

__device__ __forceinline__ void phase3(const Params& p) {
    const int gtid = blockIdx.x * 512 + otid(), gth = gridDim.x * 512;
    const bf16_t* LO = (const bf16_t*)(p.ws + WS_LO); bf16_t* LA = (bf16_t*)(p.ws + WS_LA); const float* mu = p.in[I_MU] + 1536;
    const int c0 = (gtid & 31) * 8;
    float m[8];
#pragma unroll
    for (int j = 0; j < 8; ++j) m[j] = mu[c0 + j];
    for (int base = gtid; base < NT * 32; base += 4 * gth) {
        u32x4 cur[4], prv[4];
#pragma unroll
        for (int k = 0; k < 4; ++k) { const int it = base + k * gth; cur[k] = (u32x4){0u, 0u, 0u, 0u}; prv[k] = (u32x4){0u, 0u, 0u, 0u};
            if (it < NT * 32) { const int t = it >> 5; cur[k] = ldnt((const u32x4*)(LO + (size_t)t * 256 + c0)); if ((t & (SEQ - 1)) != 0) prv[k] = *(const u32x4*)(LO + (size_t)(t - 1) * 256 + c0); } }
#pragma unroll
        for (int k = 0; k < 4; ++k) { const int it = base + k * gth;
            if (it < NT * 32) { const int t = it >> 5; float zc[8], zp[8], o[8]; unpack8(cur[k], zc); unpack8(prv[k], zp);
#pragma unroll
                for (int j = 0; j < 8; ++j) { const float z = zc[j] + m[j] * (zp[j] - zc[j]); o[j] = (c0 < 64) ? tanhf_(z) : (c0 < 128 ? z : sigmoidf_(z)); }
                *(u32x4*)(LA + (size_t)t * 256 + c0) = pack8a(o); } }
    }
}

__device__ __forceinline__ void s5_carry(const Params& p, int item) {
    const int lane = otid() & 63, g = item >> 2, b = item & 3;
    const float dt = expf(p.in[I_SLDT][g]); const float are = p.in[I_SARE][g * 64 + lane], aim = p.in[I_SAIM][g * 64 + lane];
    const float mag = expf(16.0f * dt * are), ang = 16.0f * dt * aim, ar = mag * cosf(ang), ai = mag * sinf(ang);
    const bf16_t* SLOC = (const bf16_t*)(p.ws + WS_SLOC); bf16_t* USIN = (bf16_t*)(p.ws + WS_USIN);
    float sr = 0.f, si = 0.f;
    const size_t r0 = (size_t)g * 2048 + b * 512;
    for (int c0 = 0; c0 < 512; c0 += 32) {
        unsigned short lr[32], li[32];
#pragma unroll
        for (int j = 0; j < 32; ++j) { lr[j] = SLOC[(r0 + c0 + j) * 128 + lane]; li[j] = SLOC[(r0 + c0 + j) * 128 + 64 + lane]; }
#pragma unroll
        for (int j = 0; j < 32; ++j) {
            bf16_t* dst = USIN + (r0 + c0 + j) * 384 + 256;
            dst[lane] = f2bf(sr); dst[64 + lane] = f2bf(si);
            const float nr = ar * sr - ai * si + bf2f(lr[j]), ni = ar * si + ai * sr + bf2f(li[j]);
            sr = nr; si = ni;
        }
    }
}

__device__ __forceinline__ void rwkv_prepass(const Params& p, int cidx) {
    const int lane = otid() & 63, c0 = lane * 8;
    unsigned char* ws = p.ws;
    const bf16_t* R = (const bf16_t*)(ws + WS_R); const bf16_t* K = (const bf16_t*)(ws + WS_K); const bf16_t* V = (const bf16_t*)(ws + WS_V);
    const bf16_t* W = (const bf16_t*)(ws + WS_W); const bf16_t* AA = (const bf16_t*)(ws + WS_AA);
    bf16_t* WR = (bf16_t*)(ws + WS_WR); bf16_t* KP = (bf16_t*)(ws + WS_KP); bf16_t* AL = (bf16_t*)(ws + WS_AL); bf16_t* BE = (bf16_t*)(ws + WS_BE); bf16_t* VS = (bf16_t*)(ws + WS_VS);
    f32x4* SC = (f32x4*)(ws + WS_SC);
    (void)cidx;
    float mur[8], muk[8], muv[8], kkc[8], kac[8], rkc[8];
#pragma unroll
    for (int j = 0; j < 8; ++j) { mur[j] = p.in[I_MU][c0 + j]; muk[j] = p.in[I_MU][512 + c0 + j]; muv[j] = p.in[I_MU][1024 + c0 + j]; kkc[j] = p.in[I_KK][c0 + j]; kac[j] = p.in[I_KA][c0 + j]; rkc[j] = p.in[I_RK][c0 + j]; }
    struct Row { u32x4 r, k, v, a, w; };
#define PRE_LD(d, t) do { const size_t e_ = (size_t)(t) * 512 + c0; d.r = ldnt((const u32x4*)(R + e_)); d.k = ldnt((const u32x4*)(K + e_)); d.v = ldnt((const u32x4*)(V + e_)); d.a = ldnt((const u32x4*)(AA + e_)); \
        d.w = *(const u32x4*)(W + e_); } while (0)
    const int gw_ = blockIdx.x * 8 + (otid() >> 6), nw_ = gridDim.x * 8;
    for (int it = gw_; it < NT / 8; it += nw_) {
        const int t0 = it * 8;
        float rp[8], kp[8], vp[8];
        if ((t0 & (SEQ - 1)) != 0) { const size_t e = (size_t)(t0 - 1) * 512 + c0; unpack8(*(const u32x4*)(R + e), rp); unpack8(*(const u32x4*)(K + e), kp); unpack8(*(const u32x4*)(V + e), vp); }
        else {
#pragma unroll
            for (int j = 0; j < 8; ++j) { rp[j] = 0.f; kp[j] = 0.f; vp[j] = 0.f; } }
        Row cur, nxt; PRE_LD(cur, t0);
#pragma unroll
        for (int tt = 0; tt < 8; ++tt) {
            const int t = t0 + tt;
            if (tt + 1 < 8) PRE_LD(nxt, t + 1);
            float rc[8], kc[8], vc[8], a[8]; unpack8(cur.r, rc); unpack8(cur.k, kc); unpack8(cur.v, vc); unpack8(cur.a, a);
            float w[8]; unpack8(cur.w, w);
#pragma unroll
            for (int j = 0; j < 8; ++j) w[j] = __expf(-w[j]);
            float r[8], k[8], v[8], kk[8], k2[8], be[8], o[8]; float ss = 0.f;
#pragma unroll
            for (int j = 0; j < 8; ++j) { r[j] = rc[j] + mur[j] * (rp[j] - rc[j]); k[j] = kc[j] + muk[j] * (kp[j] - kc[j]); v[j] = vc[j] + muv[j] * (vp[j] - vc[j]); kk[j] = k[j] * kkc[j]; ss += kk[j] * kk[j]; }
            ss = red8(ss); const float inv = 1.0f / fmaxf(sqrtf(ss), 1e-12f);
            float br = 0.f, kr = 0.f, bc = 0.f;
#pragma unroll
            for (int j = 0; j < 8; ++j) { kk[j] *= inv; k2[j] = k[j] * (1.0f + (a[j] - 1.0f) * kac[j]); be[j] = kk[j] * a[j]; br += be[j] * r[j]; kr += k2[j] * r[j]; bc += r[j] * k2[j] * rkc[j]; }
            br = red8(br); kr = red8(kr); bc = red8(bc);
            const size_t e = (size_t)t * 512 + c0;
#pragma unroll
            for (int j = 0; j < 8; ++j) o[j] = w[j] * r[j];
            *(u32x4*)(WR + e) = pack8a(o); *(u32x4*)(KP + e) = pack8a(k2);
#pragma unroll
            for (int j = 0; j < 8; ++j) o[j] = -kk[j];
            *(u32x4*)(AL + e) = pack8a(o); *(u32x4*)(BE + e) = pack8a(be); *(u32x4*)(VS + e) = pack8a(v);
            if ((lane & 7) == 0) SC[(size_t)t * 8 + (lane >> 3)] = (f32x4){br, kr, bc, 0.f};
#pragma unroll
            for (int j = 0; j < 8; ++j) { rp[j] = rc[j]; kp[j] = kc[j]; vp[j] = vc[j]; }
            cur = nxt;
        }
    }
#undef PRE_LD
}

constexpr int CH = 32;
constexpr int HSEQ = SEQ / 2;
constexpr int CB_AL = 0, CB_BE = 8192, CB_KP = 16384, CB_WR = 24576, CB_W = 32768, CB_VS = 40960, CB_Y = 49152, CB_BYTES = 53248;
struct ScanRegs { u32x4 al, be, kp, wr, w; f32x2 sca, scb; u32x4 vs; };
__device__ __forceinline__ void scan_load(const Params& p, ScanRegs& r, int lt, size_t tg0, int h, int row0, bool phi) {
    unsigned char* ws = p.ws;
    const int tok = lt >> 3, part = lt & 7; const size_t e = (tg0 + tok) * 512 + h * 64 + part * 8;
    r.al = *(const u32x4*)((const bf16_t*)(ws + WS_AL) + e); r.be = *(const u32x4*)((const bf16_t*)(ws + WS_BE) + e);
    r.kp = *(const u32x4*)((const bf16_t*)(ws + WS_KP) + e); r.wr = *(const u32x4*)((const bf16_t*)(ws + WS_WR) + e);
    r.w = *(const u32x4*)((const bf16_t*)(ws + WS_W) + e);
    { const f32x4 s4 = ((const f32x4*)(ws + WS_SC))[(tg0 + tok) * 8 + h]; r.sca = (f32x2){s4[0], s4[1]}; }
    if (lt < 4 * CH) { r.vs = (u32x4){0u, 0u, 0u, 0u}; const f32x4 s4 = ((const f32x4*)(ws + WS_SC))[(tg0 + (lt >> 2)) * 8 + h]; r.scb = (f32x2){s4[0], s4[1]};
        if (!phi) r.vs = *(const u32x4*)((const bf16_t*)(ws + WS_VS) + (tg0 + (lt >> 2)) * 512 + h * 64 + row0 + (lt & 3) * 8); }
}
__device__ __forceinline__ void st_bf8_f32(LAS unsigned char* dst, u32x4 v) {
    *(LAS f32x4*)dst = (f32x4){bflo(v.x), bfhi(v.x), bflo(v.y), bfhi(v.y)}; *(LAS f32x4*)(dst + 16) = (f32x4){bflo(v.z), bfhi(v.z), bflo(v.w), bfhi(v.w)};
}
__device__ __forceinline__ void scan_store(LAS unsigned char* buf, const ScanRegs& r, int lt) {
    const int o = (lt >> 3) * 256 + (lt & 7) * 32;
    st_bf8_f32(buf + CB_AL + o, r.al); st_bf8_f32(buf + CB_BE + o, r.be); st_bf8_f32(buf + CB_KP + o, r.kp);
    { const float br = r.sca[0]; float a[8], wv[8]; unpack8(r.al, a); unpack8(r.wr, wv);
        *(LAS f32x4*)(buf + CB_WR + o) = (f32x4){wv[0] + br * a[0], wv[1] + br * a[1], wv[2] + br * a[2], wv[3] + br * a[3]};
        *(LAS f32x4*)(buf + CB_WR + o + 16) = (f32x4){wv[4] + br * a[4], wv[5] + br * a[5], wv[6] + br * a[6], wv[7] + br * a[7]}; }
    { float e8[8]; unpack8(r.w, e8);
        *(LAS f32x4*)(buf + CB_W + o) = (f32x4){__expf(-e8[0]), __expf(-e8[1]), __expf(-e8[2]), __expf(-e8[3])}; *(LAS f32x4*)(buf + CB_W + o + 16) = (f32x4){__expf(-e8[4]), __expf(-e8[5]), __expf(-e8[6]), __expf(-e8[7])}; }
    if (lt < 4 * CH) { LAS unsigned char* d = buf + CB_VS + (lt >> 2) * 256 + (lt & 3) * 64; const float kr = r.scb[1];
        float v[8]; unpack8(r.vs, v);
#pragma unroll
        for (int i = 0; i < 8; i += 2) *(LAS f32x4*)(d + i * 8) = (f32x4){v[i], v[i] * kr, v[i + 1], v[i + 1] * kr}; }
}
__device__ __forceinline__ void scan_yout(LAS unsigned char* buf, int tid, bf16_t* dst  ) {
    if (tid < 4 * CH) {
        const int tok = tid >> 2, qt = tid & 3;
        const f32x4 a = *(const LAS f32x4*)(buf + CB_Y + tok * 128 + qt * 32), b = *(const LAS f32x4*)(buf + CB_Y + tok * 128 + qt * 32 + 16);
        *(u32x4*)(dst + (size_t)tok * 512 + qt * 8) = pack8(a, b);
    }
}
__device__ __forceinline__ void rwkv_scan(const Params& p, int sb, LAS unsigned char* lds) {
    const int tid = otid(), wave = __builtin_amdgcn_readfirstlane(tid >> 6), lane = tid & 63;
    const int jj = sb >> 3, hh = (sb & 7) * 4 + jj / 6, role = jj % 6, b = hh >> 3, h = hh & 7, row0 = (role & 1) * 32, kind = role >> 1;
    const bool phi = (kind == 2);
    const size_t tg = (size_t)b * SEQ + (kind == 0 ? 0 : HSEQ);
    bf16_t* ydst = phi ? (bf16_t*)(p.ws + WS_YPHI) + ((size_t)b * HSEQ) * 512 + h * 64 + row0 : (bf16_t*)(p.ws + WS_Y) + tg * 512 + h * 64 + row0;
    constexpr int NCH = HSEQ / CH;
    const bool loader = wave >= 4; const int lt = tid - 256;
    ScanRegs rg;
    if (loader) { scan_load(p, rg, lt, tg, h, row0, phi); scan_store(lds, rg, lt); scan_load(p, rg, lt, tg + CH, h, row0, phi); }
    __syncthreads();
    const int rl = (wave & 3) * 8 + (lane >> 3), ko = lane & 7;
    float S[8];
#pragma unroll
    for (int i = 0; i < 8; ++i) S[i] = (phi && (row0 + rl == ko * 8 + i)) ? 1.f : 0.f;
    for (int c = 0; c < NCH; ++c) {
        LAS unsigned char* buf = lds + (c & 1) * CB_BYTES;
        LAS unsigned char* nb = lds + ((c + 1) & 1) * CB_BYTES;
        if (loader) {
            if (c > 0) scan_yout(nb, lt, ydst + (size_t)(c - 1) * CH * 512);
            if (c + 1 < NCH) scan_store(nb, rg, lt);
            if (c + 2 < NCH) scan_load(p, rg, lt, tg + (size_t)(c + 2) * CH, h, row0, phi);
        } else {
            __builtin_amdgcn_s_setprio(3);
            const LAS unsigned char* bq = buf + ko * 32;
            struct StepIn { f32x4 al0, al1, wq0, wq1, be0, be1, kp0, kp1, w0, w1; f32x2 rec; };
#define SCAN_LD(d, s) do { d.al0 = *(const LAS f32x4*)(bq + CB_AL + (s) * 256); d.al1 = *(const LAS f32x4*)(bq + CB_AL + (s) * 256 + 16); d.wq0 = *(const LAS f32x4*)(bq + CB_WR + (s) * 256); d.wq1 = *(const LAS f32x4*)(bq + CB_WR + (s) * 256 + 16); \
        d.be0 = *(const LAS f32x4*)(bq + CB_BE + (s) * 256); d.be1 = *(const LAS f32x4*)(bq + CB_BE + (s) * 256 + 16); d.kp0 = *(const LAS f32x4*)(bq + CB_KP + (s) * 256); d.kp1 = *(const LAS f32x4*)(bq + CB_KP + (s) * 256 + 16); \
        d.w0 = *(const LAS f32x4*)(bq + CB_W + (s) * 256); d.w1 = *(const LAS f32x4*)(bq + CB_W + (s) * 256 + 16); d.rec = *(const LAS f32x2*)(buf + CB_VS + (s) * 256 + rl * 8); } while (0)
            StepIn cur, n1;
            SCAN_LD(cur, 0);
#pragma unroll
            for (int s = 0; s < CH; ++s) {
                if (s + 1 < CH) SCAN_LD(n1, s + 1);
                const float al[8] = {cur.al0[0], cur.al0[1], cur.al0[2], cur.al0[3], cur.al1[0], cur.al1[1], cur.al1[2], cur.al1[3]};
                const float wq[8] = {cur.wq0[0], cur.wq0[1], cur.wq0[2], cur.wq0[3], cur.wq1[0], cur.wq1[1], cur.wq1[2], cur.wq1[3]};
                const float be[8] = {cur.be0[0], cur.be0[1], cur.be0[2], cur.be0[3], cur.be1[0], cur.be1[1], cur.be1[2], cur.be1[3]};
                const float kp[8] = {cur.kp0[0], cur.kp0[1], cur.kp0[2], cur.kp0[3], cur.kp1[0], cur.kp1[1], cur.kp1[2], cur.kp1[3]};
                const float w[8] = {cur.w0[0], cur.w0[1], cur.w0[2], cur.w0[3], cur.w1[0], cur.w1[1], cur.w1[2], cur.w1[3]};
                f32x2 t0 = (f32x2){S[0], S[1]} * (f32x2){al[0], al[1]}, t1 = (f32x2){S[0], S[1]} * (f32x2){wq[0], wq[1]};
#pragma unroll
                for (int i = 2; i < 8; i += 2) { t0 = (f32x2){S[i], S[i + 1]} * (f32x2){al[i], al[i + 1]} + t0; t1 = (f32x2){S[i], S[i + 1]} * (f32x2){wq[i], wq[i + 1]} + t1; }
                const float sa = red8(t0[0] + t0[1]);
                const float y = red8(t1[0] + t1[1]) + cur.rec[1];
                const f32x2 sa2 = (f32x2){sa, sa}, vv2 = (f32x2){cur.rec[0], cur.rec[0]};
#pragma unroll
                for (int i = 0; i < 8; i += 2) { const f32x2 sn = (f32x2){S[i], S[i + 1]} * (f32x2){w[i], w[i + 1]} + sa2 * (f32x2){be[i], be[i + 1]} + vv2 * (f32x2){kp[i], kp[i + 1]}; S[i] = sn[0]; S[i + 1] = sn[1]; }
                *(LAS float*)(buf + CB_Y + s * 128 + rl * 4) = y;
                cur = n1;
            }
#undef SCAN_LD
            __builtin_amdgcn_s_setprio(0);
        }
        __syncthreads();
    }
    if (loader) scan_yout(lds + ((NCH - 1) & 1) * CB_BYTES, lt, ydst + (size_t)(NCH - 1) * CH * 512);
    if (kind == 0 && wave < 4) { float* d = (float*)(p.ws + WS_SH) + ((size_t)hh * 64 + row0 + rl) * 64 + ko * 8;
        *(f32x4*)d = (f32x4){S[0], S[1], S[2], S[3]}; *(f32x4*)(d + 4) = (f32x4){S[4], S[5], S[6], S[7]}; }
    __syncthreads();
}
typedef float f32x16 __attribute__((ext_vector_type(16)));
__device__ __forceinline__ void rwkv_fixup(const Params& p) {
    const int tid = otid(), lane = tid & 63, gw = blockIdx.x * 8 + (tid >> 6), nw = gridDim.x * 8, r = lane & 31, hf = lane >> 5;
    const bf16_t* YPHI = (const bf16_t*)(p.ws + WS_YPHI); const float* SH = (const float*)(p.ws + WS_SH); bf16_t* Y = (bf16_t*)(p.ws + WS_Y);
    for (int u = gw; u < 32 * (HSEQ / 32); u += nw) {
        const int hh = u / (HSEQ / 32), tile = u % (HSEQ / 32), b = hh >> 3, h = hh & 7;
        const size_t tphi = (size_t)b * HSEQ + tile * 32, t0 = (size_t)b * SEQ + HSEQ + tile * 32;
        bf16x8 af[4];
#pragma unroll
        for (int s = 0; s < 4; ++s) af[s] = *(const bf16x8*)(YPHI + (tphi + r) * 512 + h * 64 + 16 * s + 8 * hf);
#pragma unroll
        for (int vt = 0; vt < 2; ++vt) {
            const float* srow = SH + ((size_t)hh * 64 + vt * 32 + r) * 64;
            f32x16 acc;
#pragma unroll
            for (int i = 0; i < 16; ++i) acc[i] = 0.f;
#pragma unroll
            for (int s = 0; s < 4; ++s) {
                const f32x4 x0 = *(const f32x4*)(srow + 16 * s + 8 * hf), x1 = *(const f32x4*)(srow + 16 * s + 8 * hf + 4);
                const u32x4 w = pack8(x0, x1); bf16x8 bfr = __builtin_bit_cast(bf16x8, w);
                acc = __builtin_amdgcn_mfma_f32_32x32x16_bf16(af[s], bfr, acc, 0, 0, 0);
            }
#pragma unroll
            for (int i = 0; i < 16; ++i) {
                const int row = (i & 3) + 8 * (i >> 2) + 4 * hf;
                bf16_t* yp = Y + (t0 + row) * 512 + h * 64 + vt * 32 + r;
                *yp = f2bf(bf2f(*yp) + acc[i]);
            }
        }
    }
}

__device__ __forceinline__ void phase8(const Params& p) {
    const int tid = otid(), lane = tid & 63, c0 = lane * 8, gw = blockIdx.x * 8 + (tid >> 6), nw = gridDim.x * 8;
    unsigned char* ws = p.ws;
    const bf16_t* Y = (const bf16_t*)(ws + WS_Y); const bf16_t* VS = (const bf16_t*)(ws + WS_VS); const bf16_t* G = (const bf16_t*)(ws + WS_G); const bf16_t* GLUO = (const bf16_t*)(ws + WS_GLUO);
    const f32x4* SC = (const f32x4*)(ws + WS_SC);
    bf16_t* MIX = (bf16_t*)(ws + WS_MIX);
    float lnw[8], lnb[8];
#pragma unroll
    for (int j = 0; j < 8; ++j) { lnw[j] = p.in[I_LNW][c0 + j]; lnb[j] = p.in[I_LNB][c0 + j]; }
    struct Row { u32x4 y, v, g; f32x4 sc; };
#define P8_LD(d, t) do { const size_t e_ = (size_t)(t) * 512 + c0; d.y = ldnt((const u32x4*)(Y + e_)); d.v = ldnt((const u32x4*)(VS + e_)); d.g = ldnt((const u32x4*)(G + e_)); \
        d.sc = SC[(size_t)(t) * 8 + (lane >> 3)]; } while (0)
    const int per = (NT + nw - 1) / nw, tbeg = gw * per, tend = (tbeg + per < NT) ? tbeg + per : NT;
    if (tbeg >= NT) return;
    Row cur, nxt; P8_LD(cur, tbeg);
    for (int t = tbeg; t < tend; ++t) {
        if (t + 1 < tend) P8_LD(nxt, t + 1);
        float y[8], v[8], g[8], o[8]; unpack8(cur.y, y); unpack8(cur.v, v); unpack8(cur.g, g);
        float sm = 0.f;
#pragma unroll
        for (int j = 0; j < 8; ++j) sm += y[j];
        const float mean = red8(sm) * (1.0f / 64.0f); float sq = 0.f;
#pragma unroll
        for (int j = 0; j < 8; ++j) { y[j] -= mean; sq += y[j] * y[j]; }
        const float rstd = rsqrtf(red8(sq) * (1.0f / 64.0f) + 64e-5f), bc = cur.sc[2];
#pragma unroll
        for (int j = 0; j < 8; ++j) o[j] = (y[j] * rstd * lnw[j] + lnb[j] + bc * v[j]) * g[j];
        *(u32x4*)(MIX + (size_t)t * 1024 + c0) = pack8a(o);
        cur = nxt;
    }
#undef P8_LD
}

__device__ __forceinline__ void s5_mix_half(const Params& p, int b2, int G2) {
    const int tid = otid(), lane = tid & 63, c0 = lane * 8, gw = b2 * 8 + (tid >> 6), nw = G2 * 8;
    const bf16_t* GLUO = (const bf16_t*)(p.ws + WS_GLUO); const float* rss5 = (const float*)(p.ws + WS_SMALL + SM_RSP5); bf16_t* MIX = (bf16_t*)(p.ws + WS_MIX);
    float gain[8];
#pragma unroll
    for (int j = 0; j < 8; ++j) gain[j] = p.in[I_SGAIN][c0 + j];
    for (int t0 = gw * 4; t0 < NT; t0 += nw * 4) {
        u32x4 gv[4]; float rs[4];
#pragma unroll
        for (int k = 0; k < 4; ++k) { gv[k] = *(const u32x4*)(GLUO + (size_t)(t0 + k) * 512 + c0); const f32x4* rp = (const f32x4*)(rss5 + (size_t)(t0 + k) * 8); const f32x4 q4 = rp[0] + rp[1]; rs[k] = rsqrtf(((q4[0] + q4[1]) + (q4[2] + q4[3])) * (1.0f / 512.0f) + 1e-6f); }
#pragma unroll
        for (int k = 0; k < 4; ++k) { float o[8]; unpack8(gv[k], o);
#pragma unroll
            for (int j = 0; j < 8; ++j) o[j] = o[j] * rs[k] * gain[j];
            *(u32x4*)(MIX + (size_t)(t0 + k) * 1024 + 512 + c0) = pack8a(o); }
    }
}

__device__ __forceinline__ void phase12(const Params& p) {
    const int tid = otid(), lane = tid & 63, gw = blockIdx.x * 8 + (tid >> 6), nw = gridDim.x * 8;
    const float* rss3 = (const float*)(p.ws + WS_RSP3); const bf16_t* X2 = (const bf16_t*)(p.ws + WS_X2B);
    f32x4 g[4];
#pragma unroll
    for (int i = 0; i < 4; ++i) g[i] = *(const f32x4*)(p.in[I_FGAIN] + i * 256 + lane * 4);
    for (int row0 = gw * 2; row0 < NT; row0 += nw * 2) {
        u32x2 xb[2][4]; float rs[2];
#pragma unroll
        for (int r = 0; r < 2; ++r) { const f32x4* rp = (const f32x4*)(rss3 + (size_t)(row0 + r) * 16); const f32x4 q4 = (rp[0] + rp[1]) + (rp[2] + rp[3]); rs[r] = rsqrtf(((q4[0] + q4[1]) + (q4[2] + q4[3])) * (1.0f / 1024.0f) + 1e-6f);
#pragma unroll
            for (int i = 0; i < 4; ++i) xb[r][i] = ldnt((const u32x2*)(X2 + (size_t)(row0 + r) * 1024 + i * 256 + lane * 4)); }
#pragma unroll
        for (int r = 0; r < 2; ++r)
#pragma unroll
            for (int i = 0; i < 4; ++i) { const f32x4 v = (f32x4){bflo(xb[r][i].x), bfhi(xb[r][i].x), bflo(xb[r][i].y), bfhi(xb[r][i].y)};
                stnt((f32x4*)(p.out + (size_t)(row0 + r) * 1024 + i * 256 + lane * 4), v * rs[r] * g[i]); }
    }
}

__device__ __forceinline__ void fast_barrier(unsigned* ctr, unsigned target, unsigned ep) {
    asm volatile("s_waitcnt vmcnt(0) lgkmcnt(0)" ::: "memory");
    __syncthreads();
    if (otid() == 0) {
        __builtin_amdgcn_fence(__ATOMIC_RELEASE, "agent");
        asm volatile("s_waitcnt vmcnt(0)" ::: "memory");
        const unsigned old = __hip_atomic_fetch_add(ctr, 1u, __ATOMIC_RELAXED, __HIP_MEMORY_SCOPE_AGENT);
        if (old + 1u == target) __hip_atomic_store(ctr + 64, ep, __ATOMIC_RELAXED, __HIP_MEMORY_SCOPE_AGENT);
        else while (__hip_atomic_load(ctr + 64, __ATOMIC_RELAXED, __HIP_MEMORY_SCOPE_AGENT) < ep) __builtin_amdgcn_s_sleep(1);
        __builtin_amdgcn_fence(__ATOMIC_ACQUIRE, "agent");
        asm volatile("s_waitcnt vmcnt(0)" ::: "memory");
    }
    __syncthreads();
}
__device__ __attribute__((noinline)) void gsync() { cg::this_grid().sync(); }
__global__ void __launch_bounds__(512) fwd_megakernel(Params p_arg) {
    const Params& p = *(const Params*)__builtin_amdgcn_kernarg_segment_ptr();
    extern __shared__ __attribute__((aligned(16))) unsigned char lds_raw[];
    LAS unsigned char* lds = (LAS unsigned char*)lds_raw;
    unsigned char* ws = p.ws;
    const int G = gridDim.x, blk = blockIdx.x;
    float* ada = (float*)(ws + WS_SMALL + SM_ADA);
    unsigned gep = 0; unsigned* gctr = (unsigned*)(ws + WS_SMALL + SM_CTR) + 256;
#define GBAR() do { ++gep; fast_barrier(gctr, gep * (unsigned)G, gep); } while (0)

    if (gridDim.x == 0x7fffffffu) gsync();
    REP(0) { phase0(p, lds, rep_ == 0); GBAR(); }
    REP(1) { phase1(p); GBAR(); }
    REP(2) {
        pg8::Gemm g{(const bf16_t*)(ws + WS_A1), (const bf16_t*)(ws + WS_WIN_T), NT, DIN, 1024, 1024, 1024, 30, 0};
        pg8::StaticOrder S; S.init(NT, DIN, G, blk);
        EpiIn E{(bf16_t*)(ws + WS_R), (const float*)(ws + WS_SMALL + SM_RSTD1), (const float*)(ws + WS_SMALL + SM_BIAS1)};
        pg8::gemm_phase(lds, g, S, E);
        {   const int nun = (NT / 256) * (DIN / 256), rem = nun % G;
            if (rep_ == 0) { if (rem == 0) deferred_setup(p, lds, blk, G); else if (blk >= rem) deferred_setup(p, lds, blk - rem, G - rem); } }
        GBAR();
    }
    REP(3) { phase3(p); GBAR(); }
    REP(4) {
        pg8::Gemm g{(const bf16_t*)(ws + WS_LA), (const bf16_t*)(ws + WS_LORA_T), NT, 1024, 128, 256, 256, 30, 0};
        pg8::StaticOrder S; S.init(NT, 1024, G, blk);
        EpiLora E{(bf16_t*)(ws + WS_W), (bf16_t*)(ws + WS_AA), (bf16_t*)(ws + WS_G), p.in[I_W0], p.in[I_A0], 0};
        pg8::gemm_phase(lds, g, S, E);
        GBAR();
    }
    REP(5) { rwkv_prepass(p, rep_); GBAR(); }
    REP(7) {
        const int nsc = (G >= 256) ? 192 : (G * 3) / 4;
        if (blk < nsc) { for (int sb = blk; sb < 192; sb += nsc) rwkv_scan(p, sb, lds); }
        else if (rep_ == 0) {
            const int G2 = G - nsc, b2 = blk - nsc; unsigned* sctr = (unsigned*)(ws + WS_SMALL + SM_CTR) + 512;
            {   pg8::Gemm g2{(const bf16_t*)(ws + WS_USIN), (const bf16_t*)(ws + WS_S5W), 65536, 256, 256, 384, 256, 3, (size_t)256 * 256 * 2};
                pg8::StaticOrder S2; S2.init(65536, 256, G2, b2);
                EpiS1 E2{(bf16_t*)(ws + WS_SLOC)};
                pg8::gemm_phase(lds, g2, S2, E2); }
            fast_barrier(sctr, (unsigned)G2, 1u);
            for (int it = b2 + (otid() >> 6) * G2; it < 128; it += 8 * G2) s5_carry(p, it);
            fast_barrier(sctr, 2u * (unsigned)G2, 2u);
            {   pg8::Gemm g{(const bf16_t*)(ws + WS_USIN), (const bf16_t*)(ws + WS_S5TV), 65536, 256, 384, 384, 384, 3, (size_t)256 * 384 * 2};
                pg8::StaticOrder S; S.init(65536, 256, G2, b2);
                EpiS2 E{(const bf16_t*)(ws + WS_USIN), (bf16_t*)(ws + WS_ZZ), p.in[I_SD]};
                pg8::gemm_phase(lds, g, S, E); }
            fast_barrier(sctr, 3u * (unsigned)G2, 3u);
            {   pg8::Gemm g{(const bf16_t*)(ws + WS_ZZ), (const bf16_t*)(ws + WS_WGLU_T), NT, 512, 512, 512, 512, 30, 0};
                pg8::StaticOrder S; S.init(NT, 512, G2, b2);
                EpiGlu E{(const bf16_t*)(ws + WS_ZZ), (bf16_t*)(ws + WS_GLUO), p.in[I_BGLU], (float*)(ws + WS_SMALL + SM_RSP5)};
                pg8::gemm_phase(lds, g, S, E); }
            fast_barrier(sctr, 4u * (unsigned)G2, 4u);
            s5_mix_half(p, b2, G2);
            {   pg8::Gemm g{(const bf16_t*)(ws + WS_LA), (const bf16_t*)(ws + WS_LORA_T) + (size_t)1024 * 256, NT, 512, 256, 256, 256, 30, 0};
                pg8::StaticOrder S; S.init(NT, 512, G2, b2);
                EpiLora E{(bf16_t*)(ws + WS_W), (bf16_t*)(ws + WS_AA), (bf16_t*)(ws + WS_G), p.in[I_W0], p.in[I_A0], 4};
                pg8::gemm_phase(lds, g, S, E); }
            late_weights(p, b2 * 512 + otid(), G2 * 512);
            fast_barrier(sctr, 5u * (unsigned)G2, 5u);
            late_bias2(p, b2 * 8 + (otid() >> 6), G2 * 8);
        }
        GBAR();
    }
    REP(13) { rwkv_fixup(p); GBAR(); }
    REP(8) { phase8(p); GBAR(); }
    REP(9) {
        pg8::Gemm g{(const bf16_t*)(ws + WS_MIX), (const bf16_t*)(ws + WS_WOUT_T), NT, 1024, 1024, 1024, 1024, 30, 0};
        pg8::StaticOrder S; S.init(NT, 1024, G, blk);
        EpiOut E{p.in[I_X], (bf16_t*)(ws + WS_X1), (bf16_t*)(ws + WS_A2), ada, (float*)(ws + WS_SMALL + SM_RSP2)};
        pg8::gemm_phase(lds, g, S, E);
        GBAR();
    }
    REP(10) {
        pg8::Gemm g{(const bf16_t*)(ws + WS_A2), (const bf16_t*)(ws + WS_GU_T), NT, 5632, 1024, 1024, 1024, 30, 0};
        pg8::StaticOrder S; S.init(NT, 5632, G, blk);
        EpiGU E{(bf16_t*)(ws + WS_HMID), (const float*)(ws + WS_SMALL + SM_RSP2), (const float*)(ws + WS_SMALL + SM_BIAS2)};
        pg8::gemm_phase(lds, g, S, E);
        GBAR();
    }
    REP(11) {
        pg8::Gemm g{(const bf16_t*)(ws + WS_HMID), (const bf16_t*)(ws + WS_DOWN_T), NT, 1024, DFF, DFF, DFF, 30, 0};
        pg8::StaticOrder S; S.init(NT, 1024, G, blk);
        EpiDown E{(const bf16_t*)(ws + WS_X1), (bf16_t*)(ws + WS_X2B), ada, (float*)(ws + WS_RSP3)};
        pg8::gemm_phase(lds, g, S, E);
        GBAR();
    }
    phase12(p);
}

extern "C" void kernel_launch(void* const* d_in, const int* in_sizes, int n_in, void* d_out, int out_size, void* d_ws, size_t ws_size, hipStream_t stream) {
    constexpr int LDS_BYTES = pg8::STAGE_BYTES;
    static int grid_blocks = 0;
    if (!grid_blocks) {
        int dev = 0, cus = 0, per_cu = 0;
        hipGetDevice(&dev);
        hipDeviceGetAttribute(&cus, hipDeviceAttributeMultiprocessorCount, dev);
        hipFuncSetAttribute((const void*)fwd_megakernel, hipFuncAttributeMaxDynamicSharedMemorySize, LDS_BYTES);
        hipOccupancyMaxActiveBlocksPerMultiprocessor(&per_cu, (const void*)fwd_megakernel, 512, LDS_BYTES);
        if (per_cu < 1) per_cu = 1;
        if (per_cu > 1) per_cu = 1;
        grid_blocks = cus * per_cu;
        if (ws_size < WS_END) fprintf(stderr, "kernel_launch: workspace too small: %zu < %zu\n", ws_size, (size_t)WS_END);
        (void)hipGetLastError();
    }
    hipMemsetAsync((unsigned char*)d_ws + WS_SMALL, 0, ZERO_BYTES, stream);
    Params p{};
    for (int i = 0; i < 32; ++i) p.in[i] = (const float*)d_in[i];
    p.out = (float*)d_out; p.ws = (unsigned char*)d_ws;
    void* args[] = {&p};
    hipError_t e = hipLaunchCooperativeKernel((const void*)fwd_megakernel, dim3(grid_blocks), dim3(512), args, LDS_BYTES, stream);
    if (e != hipSuccess) fprintf(stderr, "cooperative launch failed: %s (grid %d)\n", hipGetErrorString(e), grid_blocks);
}
```

```cpp
#include <hip/hip_runtime.h>
#include <hip/hip_cooperative_groups.h>
#include <cstdio>
#include <cstdint>
namespace cg = cooperative_groups;

#define LAS __attribute__((address_space(3)))
typedef unsigned short bf16_t;
typedef short bf16x8 __attribute__((ext_vector_type(8)));
typedef float f32x4 __attribute__((ext_vector_type(4)));
typedef float f32x2 __attribute__((ext_vector_type(2)));
typedef unsigned u32x4 __attribute__((ext_vector_type(4)));
typedef unsigned u32x2 __attribute__((ext_vector_type(2)));

constexpr int NT = 32768, SEQ = 8192, NB = 4, DM = 1024, DIN = 2304, DFF = 2816, NH = 8, NG = 32;
constexpr size_t MiB = 1ull << 20;
constexpr size_t WS_WIN_T = 0;
constexpr size_t WS_LORA_T = WS_WIN_T + (size_t)2304 * 1024 * 2;
constexpr size_t WS_WGLU_T = WS_LORA_T + (size_t)1536 * 256 * 2;
constexpr size_t WS_WOUT_T = WS_WGLU_T + (size_t)512 * 512 * 2;
constexpr size_t WS_GU_T = WS_WOUT_T + (size_t)1024 * 1024 * 2;
constexpr size_t WS_DOWN_T = WS_GU_T + (size_t)5632 * 1024 * 2;
constexpr size_t WS_S5W = WS_DOWN_T + (size_t)1024 * 2816 * 2;
constexpr size_t WS_S5TV = WS_S5W + (size_t)32 * 256 * 256 * 2;
constexpr size_t WS_WEND = WS_S5TV + (size_t)32 * 256 * 384 * 2;
static_assert(WS_WEND <= 36 * MiB, "weights region");
constexpr size_t WS_SMALL = 36 * MiB;
constexpr size_t SM_CTR = 0;
constexpr size_t ZERO_BYTES = 4096;
constexpr size_t SM_ADA = ZERO_BYTES;
constexpr size_t SM_BIAS1 = SM_ADA + 4 * 6144 * 4;
constexpr size_t SM_BIAS2 = SM_BIAS1 + 4 * 2304 * 4;
constexpr size_t SM_RSTD1 = SM_BIAS2 + 4 * 5632 * 4;
constexpr size_t SM_RSP5 = SM_RSTD1 + NT * 4;
constexpr size_t SM_RSP2 = SM_RSP5 + (size_t)NT * 8 * 4;
constexpr size_t SM_END = SM_RSP2 + (size_t)NT * 16 * 4;
static_assert(SM_END <= 4 * MiB, "small region");
constexpr size_t WS_A1 = 40 * MiB;
constexpr size_t WS_WR = 40 * MiB;
constexpr size_t WS_KP = 72 * MiB;
constexpr size_t WS_MIX = 200 * MiB;
constexpr size_t WS_R = 104 * MiB;
constexpr size_t WS_K = 136 * MiB;
constexpr size_t WS_V = 168 * MiB;
constexpr size_t WS_YPHI = 104 * MiB;
constexpr size_t WS_SH = 120 * MiB;
constexpr size_t WS_ZZ = 136 * MiB;
constexpr size_t WS_GLUO = 168 * MiB;
constexpr size_t WS_LO = 200 * MiB;
constexpr size_t WS_SLOC = 200 * MiB;
constexpr size_t WS_USIN = 216 * MiB;
constexpr size_t WS_LA = 264 * MiB;
constexpr size_t WS_W = 280 * MiB;
constexpr size_t WS_AA = 344 * MiB;
constexpr size_t WS_Y = 344 * MiB;
constexpr size_t WS_G = 376 * MiB;
constexpr size_t WS_AL = 408 * MiB;
constexpr size_t WS_BE = 440 * MiB;
constexpr size_t WS_VS = 472 * MiB;
constexpr size_t WS_SC = 504 * MiB;
constexpr size_t WS_X1 = 104 * MiB;
constexpr size_t WS_X2B = 168 * MiB;
constexpr size_t WS_A2 = 40 * MiB;
constexpr size_t WS_HMID = 296 * MiB;
constexpr size_t WS_RSP3 = 508 * MiB;
constexpr size_t WS_END = 510 * MiB;
#ifndef DUP
#define DUP 0
#endif
#define REP(bit) for (int rep_ = 0; rep_ < (((DUP) >> (bit)) & 1) + 1; ++rep_)

struct Params {
    const float* in[32];
    float* out;
    unsigned char* ws;
};

__device__ __forceinline__ float bf2f(unsigned short b) { return __uint_as_float(((unsigned)b) << 16); }
__device__ __forceinline__ unsigned short f2bf(float f) { unsigned u = __float_as_uint(f); u += 0x7FFFu + ((u >> 16) & 1u); return (unsigned short)(u >> 16); }
__device__ __forceinline__ unsigned cvt_pk_bf16(float lo, float hi) { unsigned r; asm volatile("v_cvt_pk_bf16_f32 %0, %1, %2" : "=v"(r) : "v"(lo), "v"(hi)); return r; }
__device__ __forceinline__ float bflo(unsigned w) { return __uint_as_float(w << 16); }
__device__ __forceinline__ float bfhi(unsigned w) { return __uint_as_float(w & 0xffff0000u); }
__device__ __forceinline__ float sigmoidf_(float x) { return 1.0f / (1.0f + __expf(-x)); }
__device__ __forceinline__ float siluf_(float x) { return x * sigmoidf_(x); }
__device__ __forceinline__ float tanhf_(float x) { const float e = __expf(2.0f * x); return 1.0f - 2.0f / (e + 1.0f); }
__device__ __forceinline__ float gelu_tanh(float y) { const float u = 0.7978845608028654f * (y + 0.044715f * y * y * y); return 0.5f * y * (1.0f + tanhf_(u)); }
__device__ __forceinline__ float wave_sum(float v) {
#pragma unroll
    for (int o = 32; o >= 1; o >>= 1) v += __shfl_xor(v, o);
    return v;
}
template <int CTRL> __device__ __forceinline__ float dpp_f(float x) { return __builtin_bit_cast(float, __builtin_amdgcn_update_dpp(0, __builtin_bit_cast(int, x), CTRL, 0xF, 0xF, false)); }
__device__ __forceinline__ float red16(float x) { x += dpp_f<0x128>(x); x += dpp_f<0x124>(x); x += dpp_f<0x122>(x); x += dpp_f<0x121>(x); return x; }

__device__ __forceinline__ float red8(float x) { x += dpp_f<0xB1>(x); x += dpp_f<0x4E>(x); x += dpp_f<0x141>(x); return x; }
__device__ __forceinline__ void unpack8(u32x4 v, float (&o)[8]) { o[0] = bflo(v.x); o[1] = bfhi(v.x); o[2] = bflo(v.y); o[3] = bfhi(v.y); o[4] = bflo(v.z); o[5] = bfhi(v.z); o[6] = bflo(v.w); o[7] = bfhi(v.w); }
__device__ __forceinline__ u32x4 pack8a(const float (&v)[8]) { u32x4 w; w.x = cvt_pk_bf16(v[0], v[1]); w.y = cvt_pk_bf16(v[2], v[3]); w.z = cvt_pk_bf16(v[4], v[5]); w.w = cvt_pk_bf16(v[6], v[7]); return w; }
template <class T> __device__ __forceinline__ T ldnt(const T* p) { return __builtin_nontemporal_load(p); }
template <class T> __device__ __forceinline__ void stnt(T* p, T v) { __builtin_nontemporal_store(v, p); }
__device__ __forceinline__ int otid() { int t = threadIdx.x; asm volatile("" : "+v"(t)); return t; }
namespace pg8 {
constexpr int BM = 256, BK = 64, HALF = 128, HTB = HALF * BK * 2, STAGE_BYTES = 8 * HTB, NXCD = 8, WGM = 8;
__host__ __device__ __forceinline__ int lds_byte(int r, int c) { const int st = (r >> 4) * 2 + (c >> 5), rr = r & 15, cc = c & 31, ob = rr * 64 + cc * 2; return st * 1024 + (ob ^ (((ob >> 9) & 1) << 5)); }
__host__ __device__ __forceinline__ void stage_rc(int b, int& R, int& C) { const int st = b / 1024, sb = b % 1024, swz = sb ^ (((sb >> 9) & 1) << 5); R = (st >> 1) * 16 + swz / 64; C = (st & 1) * 32 + (swz % 64) / 2; }
__host__ __device__ __forceinline__ int perm32(int rho) { const int n = rho >> 4, i = rho & 15; return 8 * (i >> 2) + 4 * n + (i & 3); }

struct Unit { int pm, pn; };
struct Gemm { const bf16_t* A; const bf16_t* Bt; int M, N, K, lda, ldb, gm; size_t gstrideB; };

struct StaticOrder {
    int nM, nN, nwg, G, c;
    __host__ __device__ void init(int M, int N, int G_, int c_) { nM = M / BM; nN = N / BM; nwg = nM * nN; G = G_; c = c_; }
    __host__ __device__ bool next(int i, Unit& u) const {
        const long L = (long)i * G + c; if (L >= nwg) return false;
        int wgid = (int)L; { const int q = nwg / NXCD, r = nwg % NXCD, xcd = wgid % NXCD, off = wgid / NXCD; wgid = (xcd < r ? xcd * (q + 1) : r * (q + 1) + (xcd - r) * q) + off; }
        const int nig = WGM * nN, gid = wgid / nig, fm = gid * WGM, gsz = (nM - fm) < WGM ? (nM - fm) : WGM;
        u.pm = fm + ((wgid % nig) % gsz); u.pn = (wgid % nig) / gsz; return true;
    }
};

template <class Epi, class Sched>
__device__ __forceinline__ void gemm_phase(LAS unsigned char* lds, const Gemm g, const Sched& S, const Epi& E) {
    int tid_ = otid(); asm volatile("" : "+v"(tid_));
    const int tid = tid_, wid = __builtin_amdgcn_readfirstlane(tid >> 6), lane = tid & 63, wr = wid >> 2, wc = wid & 3, fr = lane & 15, fq = lane >> 4;
    const int K = g.K, nt = K / BK;
    unsigned voffA, voffB;
    { int R, C; stage_rc(tid * 16, R, C); const int Rb = Epi::PERM ? ((R & ~31) + perm32(R & 31)) : R;
        voffA = (unsigned)(R * g.lda + C) * 2u; voffB = (unsigned)(Rb * g.ldb + C) * 2u; }
    const size_t dA = (size_t)64 * g.lda * 2, dB = (size_t)64 * g.ldb * 2;
    const size_t kstep = (size_t)(BK * 2);
    const size_t hstepA = (size_t)HALF * g.lda * 2, hstepB = (size_t)HALF * g.ldb * 2;
    const size_t tstepA = 2 * hstepA, tstepB = 2 * hstepB;
    const unsigned ldsw = (unsigned)wid * 1024u;
    const int aoff = lds_byte(wr * 64 + fr, fq * 8), boff = lds_byte(wc * 32 + fr, fq * 8);
#define PG8_SA(b, h) (((b) * 2 + (h)) * HTB)
#define PG8_SB(b, h) ((4 + (b) * 2 + (h)) * HTB)
#define PG8_STAGE(bufoff, gbase, voff) do { _Pragma("unroll") for (int _i = 0; _i < 2; ++_i) \
        __builtin_amdgcn_global_load_lds((const unsigned*)((const char*)(gbase) + (size_t)_i * PG8_D_##voff + (voff)), (LAS unsigned*)(lds + (bufoff) + ldsw + _i * 8192), 16, 0, 0); } while (0)
#define PG8_D_voffA dA
#define PG8_D_voffB dB
#define PG8_LDA(dst, b, h) do { _Pragma("unroll") for (int m = 0; m < 4; ++m) _Pragma("unroll") for (int k = 0; k < 2; ++k) dst[m][k] = *(const LAS bf16x8*)(lds + PG8_SA(b, h) + aoff + m * 2048 + k * 1024); } while (0)
#define PG8_LDB(dst, b, h) do { _Pragma("unroll") for (int n = 0; n < 2; ++n) _Pragma("unroll") for (int k = 0; k < 2; ++k) dst[n][k] = *(const LAS bf16x8*)(lds + PG8_SB(b, h) + boff + n * 2048 + k * 1024); } while (0)
#define PG8_MMA(ai, bj, At, Bt) do { __builtin_amdgcn_s_setprio(1); _Pragma("unroll") for (int m = 0; m < 4; ++m) _Pragma("unroll") for (int n = 0; n < 2; ++n) _Pragma("unroll") for (int k = 0; k < 2; ++k) \
        acc[ai][bj][m][n] = __builtin_amdgcn_mfma_f32_16x16x32_bf16(Bt[n][k], At[m][k], acc[ai][bj][m][n], 0, 0, 0); __builtin_amdgcn_s_setprio(0); } while (0)
#define PG8_WAIT_V(n) asm volatile("s_waitcnt vmcnt(" #n ")" ::: "memory")
#define PG8_WAIT_L(n) asm volatile("s_waitcnt lgkmcnt(" #n ")" ::: "memory")
#define PG8_BAR __builtin_amdgcn_s_barrier()
#define PG8_SCHED __builtin_amdgcn_sched_barrier(0)
    Unit cur, nxt; int ui = 0;
    if (!S.next(0, cur)) return;
    cur.pm = __builtin_amdgcn_readfirstlane(cur.pm); cur.pn = __builtin_amdgcn_readfirstlane(cur.pn);
    f32x4 acc[2][2][4][2];
#pragma unroll
    for (int a = 0; a < 2; ++a)
#pragma unroll
        for (int b = 0; b < 2; ++b)
#pragma unroll
            for (int m = 0; m < 4; ++m)
#pragma unroll
                for (int n = 0; n < 2; ++n) acc[a][b][m][n] = (f32x4){0.f, 0.f, 0.f, 0.f};
    bf16x8 At[4][2], B0[2][2], B1[2][2];
    const char* cA = (const char*)g.A + (size_t)cur.pm * tstepA;
    const char* cB = (const char*)g.Bt + (size_t)(cur.pm >> g.gm) * g.gstrideB + (size_t)cur.pn * tstepB;
    PG8_STAGE(PG8_SB(0, 0), cB, voffB); PG8_STAGE(PG8_SA(0, 0), cA, voffA); PG8_STAGE(PG8_SB(0, 1), cB + hstepB, voffB); PG8_STAGE(PG8_SA(0, 1), cA + hstepA, voffA);
    if (wr == 1) PG8_BAR;
    PG8_WAIT_V(4); PG8_BAR;
    PG8_STAGE(PG8_SB(1, 0), cB + kstep, voffB); PG8_STAGE(PG8_SA(1, 0), cA + kstep, voffA); PG8_STAGE(PG8_SB(1, 1), cB + hstepB + kstep, voffB);
    PG8_WAIT_V(6); PG8_BAR;
    for (;;) {
        const bool has_next = S.next(ui + 1, nxt);
        nxt.pm = __builtin_amdgcn_readfirstlane(nxt.pm); nxt.pn = __builtin_amdgcn_readfirstlane(nxt.pn);
        const char* nA = has_next ? (const char*)g.A + (size_t)nxt.pm * tstepA : cA;
        const char* nB = has_next ? (const char*)g.Bt + (size_t)(nxt.pm >> g.gm) * g.gstrideB + (size_t)nxt.pn * tstepB : cB;
        for (int t = 0; t < nt; t += 2) {
            const bool last = (t == nt - 2);
            const char* a1 = cA + (size_t)(t + 1) * kstep;
            const char* a2 = last ? nA : cA + (size_t)(t + 2) * kstep; const char* b2 = last ? nB : cB + (size_t)(t + 2) * kstep;
            const char* a3 = a2 + kstep; const char* b3 = b2 + kstep;
            PG8_LDB(B0, 0, 0); PG8_SCHED; PG8_LDA(At, 0, 0); PG8_STAGE(PG8_SA(1, 1), a1 + hstepA, voffA);
            PG8_WAIT_L(8); PG8_BAR; PG8_WAIT_L(0); PG8_MMA(0, 0, At, B0); PG8_BAR; PG8_SCHED;
            PG8_LDB(B1, 0, 1); PG8_STAGE(PG8_SB(0, 0), b2, voffB);
            PG8_BAR; PG8_WAIT_L(0); PG8_MMA(0, 1, At, B1); PG8_BAR;
            PG8_LDA(At, 0, 1); PG8_STAGE(PG8_SA(0, 0), a2, voffA);
            PG8_BAR; PG8_WAIT_L(0); PG8_MMA(1, 0, At, B0); PG8_BAR; PG8_SCHED;
            PG8_STAGE(PG8_SB(0, 1), b2 + hstepB, voffB);
            PG8_WAIT_V(6); PG8_BAR; PG8_MMA(1, 1, At, B1); PG8_BAR;
            PG8_LDB(B0, 1, 0); PG8_SCHED; PG8_LDA(At, 1, 0); PG8_STAGE(PG8_SA(0, 1), a2 + hstepA, voffA);
            PG8_WAIT_L(8); PG8_BAR; PG8_WAIT_L(0); PG8_MMA(0, 0, At, B0); PG8_BAR; PG8_SCHED;
            PG8_LDB(B1, 1, 1); PG8_STAGE(PG8_SB(1, 0), b3, voffB);
            PG8_BAR; PG8_WAIT_L(0); PG8_MMA(0, 1, At, B1); PG8_BAR;
            PG8_LDA(At, 1, 1); PG8_STAGE(PG8_SA(1, 0), a3, voffA);
            PG8_BAR; PG8_WAIT_L(0); PG8_MMA(1, 0, At, B0); PG8_BAR; PG8_SCHED;
            PG8_STAGE(PG8_SB(1, 1), b3 + hstepB, voffB);
            PG8_WAIT_V(6); PG8_BAR; PG8_MMA(1, 1, At, B1); PG8_BAR;
        }
        { const int l2 = otid() & 63; E(acc, cur, wr, wc, l2 & 15, l2 >> 4); }
        if (!has_next) break;
#pragma unroll
        for (int a = 0; a < 2; ++a)
#pragma unroll
            for (int b = 0; b < 2; ++b)
#pragma unroll
                for (int m = 0; m < 4; ++m)
#pragma unroll
                    for (int n = 0; n < 2; ++n) acc[a][b][m][n] = (f32x4){0.f, 0.f, 0.f, 0.f};
        cur = nxt; cA = nA; cB = nB; ++ui;
    }
    PG8_WAIT_V(0);
    if (wr == 0) PG8_BAR;
    PG8_BAR;
#undef PG8_SA
#undef PG8_SB
#undef PG8_STAGE
#undef PG8_D_voffA
#undef PG8_D_voffB
#undef PG8_LDA
#undef PG8_LDB
#undef PG8_MMA
#undef PG8_WAIT_V
#undef PG8_WAIT_L
#undef PG8_BAR
#undef PG8_SCHED
}
}
using pg8::Unit;

#define EPI_ROW(ai, m) (u.pm * 256 + (ai) * 128 + wr * 64 + (m) * 16 + fr)
typedef const f32x4 (&AccRef)[2][2][4][2];
__device__ __forceinline__ u32x4 pack8(f32x4 v0, f32x4 v1) { u32x4 w; w.x = cvt_pk_bf16(v0[0], v0[1]); w.y = cvt_pk_bf16(v0[2], v0[3]); w.z = cvt_pk_bf16(v1[0], v1[1]); w.w = cvt_pk_bf16(v1[2], v1[3]); return w; }

struct EpiIn {
    static constexpr bool PERM = true;
    bf16_t *R; const float* rstd1; const float* bias1;
    __device__ __forceinline__ void operator()(AccRef acc, const Unit& u, int wr, int wc, int fr, int fq) const {
        const int pn = u.pn, b = (u.pm * 256) >> 13;
        f32x4 bv[2][2];
#pragma unroll
        for (int bj = 0; bj < 2; ++bj)
#pragma unroll
            for (int n = 0; n < 2; ++n) bv[bj][n] = *(const f32x4*)(bias1 + b * DIN + pn * 256 + bj * 128 + wc * 32 + 8 * fq + 4 * n);
#pragma unroll
        for (int ai = 0; ai < 2; ++ai)
#pragma unroll
            for (int m = 0; m < 4; ++m) {
                const int row = EPI_ROW(ai, m); const float rs = rstd1[row];
#pragma unroll
                for (int bj = 0; bj < 2; ++bj) {
                    const u32x4 w = pack8(acc[ai][bj][m][0] * rs + bv[bj][0], acc[ai][bj][m][1] * rs + bv[bj][1]);
                    const int cl = bj * 128 + wc * 32 + 8 * fq;
                    size_t eo;
                    if (pn < 6) eo = (size_t)(pn >> 1) * (16u << 20) + (size_t)row * 512 + (pn & 1) * 256 + cl;
                    else if (pn == 6) eo = (WS_LO - WS_R) / 2 + (size_t)row * 256 + cl;
                    else { const int cu = (pn - 7) * 256 + cl, g = cu >> 4, ch = cu & 15; eo = (WS_USIN - WS_R) / 2 + ((size_t)(g * 2048 + (row >> 4)) * 384 + (row & 15) * 16 + ch); }
                    *(u32x4*)(R + eo) = w;
                }
            }
    }
};
struct EpiLora {
    static constexpr bool PERM = true;
    bf16_t* W; bf16_t* AA; bf16_t* G; const float* w0; const float* a0; int pn_off;
    static __device__ __forceinline__ float decay_of(float x) { return 0.6065306597126334f * sigmoidf_(x); }
    __device__ __forceinline__ void operator()(AccRef acc, const Unit& u, int wr, int wc, int fr, int fq) const {
        const int pnx = u.pn + pn_off, type = pnx >> 1, cb = (pnx & 1) * 256 + wc * 32 + 8 * fq;
        if (type == 0) {
#pragma unroll
            for (int bj = 0; bj < 2; ++bj) {
                const int c8 = cb + bj * 128; const f32x4 b0 = *(const f32x4*)(w0 + c8), b1 = *(const f32x4*)(w0 + c8 + 4);
#pragma unroll
                for (int ai = 0; ai < 2; ++ai)
#pragma unroll
                    for (int m = 0; m < 4; ++m) {
                        const int row = EPI_ROW(ai, m); f32x4 v0 = acc[ai][bj][m][0] + b0, v1 = acc[ai][bj][m][1] + b1;
#pragma unroll
                        for (int j = 0; j < 4; ++j) { v0[j] = decay_of(v0[j]); v1[j] = decay_of(v1[j]); }
                        *(u32x4*)(W + (size_t)row * 512 + c8) = pack8(v0, v1);
                    }
            }
        } else if (type == 1) {
#pragma unroll
            for (int bj = 0; bj < 2; ++bj) {
                const int c8 = cb + bj * 128; const f32x4 b0 = *(const f32x4*)(a0 + c8), b1 = *(const f32x4*)(a0 + c8 + 4);
#pragma unroll
                for (int ai = 0; ai < 2; ++ai)
#pragma unroll
                    for (int m = 0; m < 4; ++m) {
                        const int row = EPI_ROW(ai, m); f32x4 v0 = acc[ai][bj][m][0] + b0, v1 = acc[ai][bj][m][1] + b1;
#pragma unroll
                        for (int j = 0; j < 4; ++j) { v0[j] = sigmoidf_(v0[j]); v1[j] = sigmoidf_(v1[j]); }
                        *(u32x4*)(AA + (size_t)row * 512 + c8) = pack8(v0, v1);
                    }
            }
        } else {
#pragma unroll
            for (int bj = 0; bj < 2; ++bj)
#pragma unroll
                for (int ai = 0; ai < 2; ++ai)
#pragma unroll
                    for (int m = 0; m < 4; ++m) {
                        const int row = EPI_ROW(ai, m);
                        *(u32x4*)(G + (size_t)row * 512 + cb + bj * 128) = pack8(acc[ai][bj][m][0], acc[ai][bj][m][1]);
                    }
        }
    }
};
struct EpiS1 {
    static constexpr bool PERM = true;
    bf16_t* SLOC;
    __device__ __forceinline__ void operator()(AccRef acc, const Unit& u, int wr, int wc, int fr, int fq) const {
#pragma unroll
        for (int ai = 0; ai < 2; ++ai)
#pragma unroll
            for (int m = 0; m < 4; ++m) {
                const int row = EPI_ROW(ai, m);
                *(u32x4*)(SLOC + (size_t)row * 128 + wc * 32 + 8 * fq) = pack8(acc[ai][0][m][0], acc[ai][0][m][1]);
            }
    }
};
struct EpiS2 {
    static constexpr bool PERM = true;
    const bf16_t* USIN; bf16_t* ZZ; const float* dskip;
    __device__ __forceinline__ void operator()(AccRef acc, const Unit& u, int wr, int wc, int fr, int fq) const {
#pragma unroll
        for (int ai = 0; ai < 2; ++ai)
#pragma unroll
            for (int m = 0; m < 4; ++m) {
                const int row = EPI_ROW(ai, m), g = row >> 11, rig = row & 2047;
#pragma unroll
                for (int bj = 0; bj < 2; ++bj) {
                    const int col = bj * 128 + wc * 32 + 8 * fq, t = col >> 4, c = col & 15;
                    const u32x4 uu = *(const u32x4*)(USIN + (size_t)row * 384 + col);
                    const f32x4 d0 = *(const f32x4*)(dskip + g * 16 + c), d1 = *(const f32x4*)(dskip + g * 16 + c + 4);
                    f32x4 v0 = acc[ai][bj][m][0], v1 = acc[ai][bj][m][1];
                    v0[0] += d0[0] * bflo(uu.x); v0[1] += d0[1] * bfhi(uu.x); v0[2] += d0[2] * bflo(uu.y); v0[3] += d0[3] * bfhi(uu.y);
                    v1[0] += d1[0] * bflo(uu.z); v1[1] += d1[1] * bfhi(uu.z); v1[2] += d1[2] * bflo(uu.w); v1[3] += d1[3] * bfhi(uu.w);
#pragma unroll
                    for (int j = 0; j < 4; ++j) { v0[j] = gelu_tanh(v0[j]); v1[j] = gelu_tanh(v1[j]); }
                    *(u32x4*)(ZZ + (size_t)(rig * 16 + t) * 512 + g * 16 + c) = pack8(v0, v1);
                }
            }
    }
};
struct EpiGlu {
    static constexpr bool PERM = true;
    const bf16_t* ZZ; bf16_t* GLUO; const float* bglu; float* rss;
    __device__ __forceinline__ void operator()(AccRef acc, const Unit& u, int wr, int wc, int fr, int fq) const {
#pragma unroll
        for (int ai = 0; ai < 2; ++ai)
#pragma unroll
            for (int m = 0; m < 4; ++m) {
                const int row = EPI_ROW(ai, m); float ss = 0.f;
#pragma unroll
                for (int bj = 0; bj < 2; ++bj) {
                    const int col = u.pn * 256 + bj * 128 + wc * 32 + 8 * fq;
                    const u32x4 zz = *(const u32x4*)(ZZ + (size_t)row * 512 + col);
                    const f32x4 b0 = *(const f32x4*)(bglu + col), b1 = *(const f32x4*)(bglu + col + 4);
                    f32x4 v0 = acc[ai][bj][m][0] + b0, v1 = acc[ai][bj][m][1] + b1;
                    v0[0] = bflo(zz.x) * sigmoidf_(v0[0]); v0[1] = bfhi(zz.x) * sigmoidf_(v0[1]); v0[2] = bflo(zz.y) * sigmoidf_(v0[2]); v0[3] = bfhi(zz.y) * sigmoidf_(v0[3]);
                    v1[0] = bflo(zz.z) * sigmoidf_(v1[0]); v1[1] = bfhi(zz.z) * sigmoidf_(v1[1]); v1[2] = bflo(zz.w) * sigmoidf_(v1[2]); v1[3] = bfhi(zz.w) * sigmoidf_(v1[3]);
#pragma unroll
                    for (int j = 0; j < 4; ++j) ss += v0[j] * v0[j] + v1[j] * v1[j];
                    *(u32x4*)(GLUO + (size_t)row * 512 + col) = pack8(v0, v1);
                }
                ss += __shfl_xor(ss, 16); ss += __shfl_xor(ss, 32);
                if (fq == 0) rss[(size_t)row * 8 + u.pn * 4 + wc] = ss;
            }
    }
};
struct EpiOut {
    static constexpr bool PERM = true;
    const float* x; bf16_t* X1; bf16_t* A2; const float* ada; float* rss;
    __device__ __forceinline__ void operator()(AccRef acc, const Unit& u, int wr, int wc, int fr, int fq) const {
        const int b = (u.pm * 256) >> 13;
        const float* gm = ada + b * 6144 + 2048; const float* scf = ada + b * 6144 + 4096;
        f32x4 gv[2][2], sv[2][2];
#pragma unroll
        for (int bj = 0; bj < 2; ++bj)
#pragma unroll
            for (int n = 0; n < 2; ++n) { const int col = u.pn * 256 + bj * 128 + wc * 32 + 8 * fq + 4 * n; gv[bj][n] = *(const f32x4*)(gm + col); sv[bj][n] = *(const f32x4*)(scf + col) + 1.0f; }
#pragma unroll
        for (int ai = 0; ai < 2; ++ai)
#pragma unroll
            for (int m = 0; m < 4; ++m) {
                const int row = EPI_ROW(ai, m); float ss = 0.f;
#pragma unroll
                for (int bj = 0; bj < 2; ++bj) {
                    const size_t off = (size_t)row * 1024 + u.pn * 256 + bj * 128 + wc * 32 + 8 * fq;
                    const f32x4 x0 = ldnt((const f32x4*)(x + off)) + gv[bj][0] * acc[ai][bj][m][0];
                    const f32x4 x1 = ldnt((const f32x4*)(x + off + 4)) + gv[bj][1] * acc[ai][bj][m][1];
                    *(u32x4*)(X1 + off) = pack8(x0, x1);
                    ss += (x0[0] * x0[0] + x0[1] * x0[1] + x0[2] * x0[2] + x0[3] * x0[3]) + (x1[0] * x1[0] + x1[1] * x1[1] + x1[2] * x1[2] + x1[3] * x1[3]);
                    *(u32x4*)(A2 + off) = pack8(x0 * sv[bj][0], x1 * sv[bj][1]);
                }
                ss += __shfl_xor(ss, 16); ss += __shfl_xor(ss, 32);
                if (fq == 0) rss[(size_t)row * 16 + u.pn * 4 + wc] = ss;
            }
    }
};
struct EpiGU {
    static constexpr bool PERM = true;
    bf16_t* HMID; const float* rss2; const float* bias2;
    __device__ __forceinline__ void operator()(AccRef acc, const Unit& u, int wr, int wc, int fr, int fq) const {
        const int b = (u.pm * 256) >> 13;
        f32x4 bv[2][2];
#pragma unroll
        for (int bj = 0; bj < 2; ++bj)
#pragma unroll
            for (int n = 0; n < 2; ++n) bv[bj][n] = *(const f32x4*)(bias2 + b * 5632 + u.pn * 256 + bj * 128 + wc * 32 + 8 * fq + 4 * n);
#pragma unroll
        for (int ai = 0; ai < 2; ++ai)
#pragma unroll
            for (int m = 0; m < 4; ++m) {
                const int row = EPI_ROW(ai, m); const f32x4* rp = (const f32x4*)(rss2 + (size_t)row * 16); const f32x4 q4 = (rp[0] + rp[1]) + (rp[2] + rp[3]); const float rs = rsqrtf(((q4[0] + q4[1]) + (q4[2] + q4[3])) * (1.0f / 1024.0f) + 1e-6f);
                f32x4 h0, h1;
#pragma unroll
                for (int j = 0; j < 4; ++j) {
                    const float g0 = acc[ai][0][m][0][j] * rs + bv[0][0][j], u0 = acc[ai][1][m][0][j] * rs + bv[1][0][j];
                    const float g1 = acc[ai][0][m][1][j] * rs + bv[0][1][j], u1 = acc[ai][1][m][1][j] * rs + bv[1][1][j];
                    h0[j] = siluf_(g0) * u0; h1[j] = siluf_(g1) * u1;
                }
                *(u32x4*)(HMID + (size_t)row * DFF + u.pn * 128 + wc * 32 + 8 * fq) = pack8(h0, h1);
            }
    }
};
struct EpiDown {
    static constexpr bool PERM = true;
    const bf16_t* X1; bf16_t* out; const float* ada; float* rss;
    __device__ __forceinline__ void operator()(AccRef acc, const Unit& u, int wr, int wc, int fr, int fq) const {
        const int b = (u.pm * 256) >> 13;
        const float* gf = ada + b * 6144 + 5120;
        f32x4 gv[2][2];
#pragma unroll
        for (int bj = 0; bj < 2; ++bj)
#pragma unroll
            for (int n = 0; n < 2; ++n) gv[bj][n] = *(const f32x4*)(gf + u.pn * 256 + bj * 128 + wc * 32 + 8 * fq + 4 * n);
#pragma unroll
        for (int ai = 0; ai < 2; ++ai)
#pragma unroll
            for (int m = 0; m < 4; ++m) {
                const int row = EPI_ROW(ai, m); float ss = 0.f;
#pragma unroll
                for (int bj = 0; bj < 2; ++bj) {
                    const size_t off = (size_t)row * 1024 + u.pn * 256 + bj * 128 + wc * 32 + 8 * fq;
                    const u32x4 xb = ldnt((const u32x4*)(X1 + off));
                    const f32x4 x0 = (f32x4){bflo(xb.x), bfhi(xb.x), bflo(xb.y), bfhi(xb.y)} + gv[bj][0] * acc[ai][bj][m][0];
                    const f32x4 x1 = (f32x4){bflo(xb.z), bfhi(xb.z), bflo(xb.w), bfhi(xb.w)} + gv[bj][1] * acc[ai][bj][m][1];
                    *(u32x4*)(out + off) = pack8(x0, x1);
                    ss += (x0[0] * x0[0] + x0[1] * x0[1] + x0[2] * x0[2] + x0[3] * x0[3]) + (x1[0] * x1[0] + x1[1] * x1[1] + x1[2] * x1[2] + x1[3] * x1[3]);
                }
                ss += __shfl_xor(ss, 16); ss += __shfl_xor(ss, 32);
                if (fq == 0) rss[(size_t)row * 16 + u.pn * 4 + wc] = ss;
            }
    }
};

enum { I_X = 0, I_C, I_WADA, I_BADA, I_WIN, I_MU, I_W0, I_W2, I_A0, I_A2, I_G2, I_KK, I_KA, I_RK, I_LNW, I_LNB, I_SARE, I_SAIM, I_SLDT,
       I_SBRE, I_SBIM, I_SCRE, I_SCIM, I_SD, I_WGLU, I_BGLU, I_SGAIN, I_WOUT, I_FG, I_FU, I_FD, I_FGAIN };

template <class Map>
__device__ __forceinline__ void transpose_cvt(bf16_t* dst, const float* src, int Nd, int Kd, int ld, Map map, int gtid, int gthreads) {
    const int items = Nd * (Kd / 8);
    for (int it0 = gtid; it0 < items; it0 += 2 * gthreads) {
        float v[2][8];
#pragma unroll
        for (int u = 0; u < 2; ++u) { const int it = it0 + u * gthreads; if (it < items) { const int n = it % Nd, k8 = it / Nd; const int sc = map(n);
#pragma unroll
            for (int j = 0; j < 8; ++j) v[u][j] = src[(size_t)(k8 * 8 + j) * ld + sc]; } }
#pragma unroll
        for (int u = 0; u < 2; ++u) { const int it = it0 + u * gthreads; if (it < items) { const int n = it % Nd, k8 = it / Nd;
            u32x4 w; w.x = cvt_pk_bf16(v[u][0], v[u][1]); w.y = cvt_pk_bf16(v[u][2], v[u][3]); w.z = cvt_pk_bf16(v[u][4], v[u][5]); w.w = cvt_pk_bf16(v[u][6], v[u][7]);
            *(u32x4*)(dst + (size_t)n * Kd + k8 * 8) = w; } }
    }
}

__device__ __forceinline__ void s5_mats(const Params& p, int g, int part, LAS unsigned char* lds) {
    LAS float* ap_re = (LAS float*)lds;
    LAS float* ap_im = ap_re + 17 * 64;
    LAS float* bb_re = ap_im + 17 * 64;
    LAS float* bb_im = bb_re + 1024;
    LAS float* c_re = bb_im + 1024;
    LAS float* c_im = c_re + 1024;
    LAS float* ktab = c_im + 1024;
    const int tid = otid();
    const float dt = expf(p.in[I_SLDT][g]);
    const float* are_p = p.in[I_SARE] + g * 64; const float* aim_p = p.in[I_SAIM] + g * 64;
    for (int i = tid; i < 17 * 64; i += 512) { const int tau = i >> 6, pp = i & 63; const float mag = expf((float)tau * dt * are_p[pp]), ang = (float)tau * dt * aim_p[pp]; ap_re[i] = mag * cosf(ang); ap_im[i] = mag * sinf(ang); }
    for (int i = tid; i < 1024; i += 512) {
        const int pp = i >> 4;
        const float are = are_p[pp], aim = aim_p[pp], mag = expf(dt * are), abr = mag * cosf(dt * aim), abi = mag * sinf(dt * aim), den = are * are + aim * aim;
        const float pr = abr - 1.0f, q = abi, cre = (pr * are + q * aim) / den, cim = (q * are - pr * aim) / den;
        const float bre = p.in[I_SBRE][(size_t)g * 1024 + i], bim = p.in[I_SBIM][(size_t)g * 1024 + i];
        bb_re[i] = cre * bre - cim * bim; bb_im[i] = cre * bim + cim * bre;
        c_re[i] = p.in[I_SCRE][(size_t)g * 1024 + i]; c_im[i] = p.in[I_SCIM][(size_t)g * 1024 + i];
    }
    __syncthreads();
    {   const int i = tid, tau = i >> 5, cl = (i >> 4) & 1, cc = 2 * part + cl, c2 = i & 15; float s = 0.f;
        for (int pp = 0; pp < 64; ++pp) {
            const float cr = c_re[cc * 64 + pp], ci = c_im[cc * 64 + pp], ar = ap_re[tau * 64 + pp], ai = ap_im[tau * 64 + pp];
            const float xr = cr * ar - ci * ai, xi = cr * ai + ci * ar;
            s += xr * bb_re[pp * 16 + c2] - xi * bb_im[pp * 16 + c2];
        }
        ktab[i] = s; }
    __syncthreads();
    bf16_t* TV = (bf16_t*)(p.ws + WS_S5TV) + (size_t)g * 256 * 384;
    for (int i = tid; i < 32 * 384; i += 512) {
        const int rr = i / 384, kk = i % 384, t = rr >> 1, cl = rr & 1, cc = 2 * part + cl, n = t * 16 + cc; float val;
        if (kk < 256) { const int sx = kk >> 4, c2 = kk & 15; val = (sx <= t) ? ktab[(t - sx) * 32 + cl * 16 + c2] : 0.f; }
        else { const int q = kk - 256, pp = q & 63, tau = t + 1; const float cr = c_re[cc * 64 + pp], ci = c_im[cc * 64 + pp], ar = ap_re[tau * 64 + pp], ai = ap_im[tau * 64 + pp];
            val = (q < 64) ? (cr * ar - ci * ai) : -(cr * ai + ci * ar); }
        TV[(size_t)n * 384 + kk] = f2bf(val);
    }
    bf16_t* WG = (bf16_t*)(p.ws + WS_S5W) + (size_t)g * 256 * 256;
    for (int i = tid; i < 32 * 256; i += 512) {
        const int rr = i >> 8, kk = i & 255, sx = kk >> 4, c2 = kk & 15, n = (rr < 16) ? (16 * part + rr) : (128 + 16 * part + (rr - 16)); float val = 0.f;
        if (n < 128) { const int pp = n & 63, tau = 15 - sx; const float ar = ap_re[tau * 64 + pp], ai = ap_im[tau * 64 + pp], br = bb_re[pp * 16 + c2], bi = bb_im[pp * 16 + c2];
            val = (n < 64) ? (ar * br - ai * bi) : (ar * bi + ai * br); }
        WG[(size_t)n * 256 + kk] = f2bf(val);
    }
    __syncthreads();
}

__device__ __forceinline__ void phase0(const Params& p, LAS unsigned char* lds, bool do_ada) {
    const int tid = otid(), nblk = gridDim.x, blk = blockIdx.x;
    unsigned char* ws = p.ws;
    float* ada = (float*)(ws + WS_SMALL + SM_ADA);
    const int nada = (nblk >= 192) ? 96 : (nblk > 1 ? nblk / 2 : 1);
    if (blk < nada) {
        if (do_ada) {
            const int lane = tid & 63, wv = tid >> 6; LAS float* part = (LAS float*)lds;
            LAS float* sil = part + 2048;
            for (int i = tid; i < 4096; i += 512) sil[i] = siluf_(p.in[I_C][i]);
            __syncthreads();
            for (int cbk = blk; cbk < 96; cbk += nada) {
                const int col = cbk * 64 + lane; float a0 = 0.f, a1 = 0.f, a2 = 0.f, a3 = 0.f;
                const float* wp = p.in[I_WADA] + (size_t)(wv * 128) * 6144 + col; const LAS float* sp = sil + wv * 128;
                for (int k0 = 0; k0 < 128; k0 += 16) {
                    float w[16];
#pragma unroll
                    for (int j = 0; j < 16; ++j) w[j] = wp[(size_t)(k0 + j) * 6144];
#pragma unroll
                    for (int j = 0; j < 16; ++j) { a0 += sp[k0 + j] * w[j]; a1 += sp[1024 + k0 + j] * w[j]; a2 += sp[2048 + k0 + j] * w[j]; a3 += sp[3072 + k0 + j] * w[j]; }
                }
                __syncthreads();
                part[(wv * 4 + 0) * 64 + lane] = a0; part[(wv * 4 + 1) * 64 + lane] = a1; part[(wv * 4 + 2) * 64 + lane] = a2; part[(wv * 4 + 3) * 64 + lane] = a3;
                __syncthreads();
                if (tid < 256) { const int bb = tid >> 6; float sacc = p.in[I_BADA][col];
#pragma unroll
                    for (int w8 = 0; w8 < 8; ++w8) sacc += part[(w8 * 4 + bb) * 64 + lane];
                    ada[bb * 6144 + col] = sacc; }
            }
            __syncthreads();
        }
        if (nblk > nada) return;
    }
    const int tb_ = (nblk > nada) ? blk - nada : blk, tn_ = (nblk > nada) ? nblk - nada : nblk;
    const int gtid = tb_ * 512 + tid, gth = tn_ * 512;
    transpose_cvt((bf16_t*)(ws + WS_WIN_T), p.in[I_WIN], 2304, 1024, 2304, [](int n) { return n; }, gtid, gth);
}

__device__ __forceinline__ void late_weights(const Params& p, int gtid, int gth) {
    unsigned char* ws = p.ws;
    transpose_cvt((bf16_t*)(ws + WS_WOUT_T), p.in[I_WOUT], 1024, 1024, 1024, [](int n) { return n; }, gtid, gth);
    transpose_cvt((bf16_t*)(ws + WS_DOWN_T), p.in[I_FD], 1024, 2816, 1024, [](int n) { return n; }, gtid, gth);
    {
        bf16_t* dst = (bf16_t*)(ws + WS_GU_T);
        const int items = 5632 * 128;
        for (int it0 = gtid; it0 < items; it0 += 2 * gth) {
            float v[2][8];
#pragma unroll
            for (int u = 0; u < 2; ++u) { const int it = it0 + u * gth; if (it < items) { const int n = it % 5632, k8 = it / 5632, pn = n >> 8, wi = n & 255; const float* src = (wi < 128) ? p.in[I_FG] : p.in[I_FU]; const int sc = pn * 128 + (wi & 127);
#pragma unroll
                for (int j = 0; j < 8; ++j) v[u][j] = src[(size_t)(k8 * 8 + j) * DFF + sc]; } }
#pragma unroll
            for (int u = 0; u < 2; ++u) { const int it = it0 + u * gth; if (it < items) { const int n = it % 5632, k8 = it / 5632;
                u32x4 w; w.x = cvt_pk_bf16(v[u][0], v[u][1]); w.y = cvt_pk_bf16(v[u][2], v[u][3]); w.z = cvt_pk_bf16(v[u][4], v[u][5]); w.w = cvt_pk_bf16(v[u][6], v[u][7]);
                *(u32x4*)(dst + (size_t)n * 1024 + k8 * 8) = w; } }
        }
    }
}
__device__ __forceinline__ void late_bias2(const Params& p, int gw, int nw) {
    unsigned char* ws = p.ws; const int lane = otid() & 63;
    const float* ada = (const float*)(ws + WS_SMALL + SM_ADA); float* bias2 = (float*)(ws + WS_SMALL + SM_BIAS2);
    for (int n = gw; n < 5632; n += nw) {
        const bf16_t* wrow = (const bf16_t*)(ws + WS_GU_T) + (size_t)n * 1024;
        float a[4] = {0.f, 0.f, 0.f, 0.f};
#pragma unroll
        for (int i = 0; i < 2; ++i) {
            const int k0 = i * 512 + lane * 8; const u32x4 wv = *(const u32x4*)(wrow + k0);
            float wf[8]; unpack8(wv, wf);
#pragma unroll
            for (int b = 0; b < 4; ++b) { const float* sh = ada + b * 6144 + 3072 + k0;
#pragma unroll
                for (int j = 0; j < 8; ++j) a[b] += sh[j] * wf[j]; }
        }
#pragma unroll
        for (int b = 0; b < 4; ++b) a[b] = wave_sum(a[b]);
        if (lane == 0) {
#pragma unroll
            for (int b = 0; b < 4; ++b) bias2[b * 5632 + n] = a[b]; }
    }
}

__device__ __forceinline__ void deferred_setup(const Params& p, LAS unsigned char* lds, int bi, int nb) {
    unsigned char* ws = p.ws; const int tid = otid();
    for (int u = bi; u < NG * 8; u += nb) s5_mats(p, u >> 3, u & 7, lds);
    const int gtid = bi * 512 + tid, gth = nb * 512;
    transpose_cvt((bf16_t*)(ws + WS_WGLU_T), p.in[I_WGLU], 512, 512, 512, [](int n) { return n; }, gtid, gth);
    {
        bf16_t* dst = (bf16_t*)(ws + WS_LORA_T);
        const int items = 1536 * 32;
        for (int it = gtid; it < items; it += gth) {
            const int n = it % 1536, k8 = it / 1536, k0 = k8 * 8; float v[8];
#pragma unroll
            for (int j = 0; j < 8; ++j) { const int k = k0 + j; float x = 0.f;
                if (n < 512) { if (k < 64) x = p.in[I_W2][(size_t)k * 512 + n]; }
                else if (n < 1024) { if (k >= 64 && k < 128) x = p.in[I_A2][(size_t)(k - 64) * 512 + (n - 512)]; }
                else { if (k >= 128) x = p.in[I_G2][(size_t)(k - 128) * 512 + (n - 1024)]; }
                v[j] = x; }
            u32x4 w; w.x = cvt_pk_bf16(v[0], v[1]); w.y = cvt_pk_bf16(v[2], v[3]); w.z = cvt_pk_bf16(v[4], v[5]); w.w = cvt_pk_bf16(v[6], v[7]);
            *(u32x4*)(dst + (size_t)n * 256 + k0) = w;
        }
    }
}

__device__ __forceinline__ void phase1(const Params& p) {
    const int tid = otid(), lane = tid & 63, gw = blockIdx.x * 8 + (tid >> 6), nw = gridDim.x * 8;
    unsigned char* ws = p.ws;
    const float* ada = (const float*)(ws + WS_SMALL + SM_ADA);
    bf16_t* A1 = (bf16_t*)(ws + WS_A1); float* rstd1 = (float*)(ws + WS_SMALL + SM_RSTD1);
    for (int row0 = gw * 4; row0 < NT; row0 += nw * 4) {
        const int b = row0 >> 13; const float* sc = ada + b * 6144 + 1024;
        f32x4 xv[4][4];
#pragma unroll
        for (int r = 0; r < 4; ++r)
#pragma unroll
            for (int i = 0; i < 4; ++i) xv[r][i] = ldnt((const f32x4*)(p.in[I_X] + (size_t)(row0 + r) * 1024 + i * 256 + lane * 4));
        f32x4 sv[4];
#pragma unroll
        for (int i = 0; i < 4; ++i) sv[i] = *(const f32x4*)(sc + i * 256 + lane * 4) + 1.0f;
#pragma unroll
        for (int r = 0; r < 4; ++r) {
            float ss = 0.f;
#pragma unroll
            for (int i = 0; i < 4; ++i) ss += xv[r][i][0] * xv[r][i][0] + xv[r][i][1] * xv[r][i][1] + xv[r][i][2] * xv[r][i][2] + xv[r][i][3] * xv[r][i][3];
            ss = wave_sum(ss);
            if (lane == 0) rstd1[row0 + r] = rsqrtf(ss * (1.0f / 1024.0f) + 1e-6f);
#pragma unroll
            for (int i = 0; i < 4; ++i) { const f32x4 a = xv[r][i] * sv[i]; u32x2 w; w.x = cvt_pk_bf16(a[0], a[1]); w.y = cvt_pk_bf16(a[2], a[3]);
                *(u32x2*)(A1 + (size_t)(row0 + r) * 1024 + i * 256 + lane * 4) = w; }
        }
    }
    float* bias1 = (float*)(ws + WS_SMALL + SM_BIAS1); float* bias2 = (float*)(ws + WS_SMALL + SM_BIAS2);
    for (int it = gw; it < 2304; it += nw) {
        const bool first = it < 2304; const int n = first ? it : it - 2304;
        const bf16_t* wrow = first ? (const bf16_t*)(ws + WS_WIN_T) + (size_t)n * 1024 : (const bf16_t*)(ws + WS_GU_T) + (size_t)n * 1024;
        const int shoff = first ? 0 : 3072;
        float a[4] = {0.f, 0.f, 0.f, 0.f};
#pragma unroll
        for (int i = 0; i < 2; ++i) {
            const int k0 = i * 512 + lane * 8; const u32x4 wv = *(const u32x4*)(wrow + k0);
            const float wf[8] = {bflo(wv.x), bfhi(wv.x), bflo(wv.y), bfhi(wv.y), bflo(wv.z), bfhi(wv.z), bflo(wv.w), bfhi(wv.w)};
#pragma unroll
            for (int b = 0; b < 4; ++b) { const float* sh = ada + b * 6144 + shoff + k0;
#pragma unroll
                for (int j = 0; j < 8; ++j) a[b] += sh[j] * wf[j]; }
        }
#pragma unroll
        for (int b = 0; b < 4; ++b) a[b] = wave_sum(a[b]);
        if (lane == 0) { float* dst = first ? bias1 : bias2; const int ld = first ? 2304 : 5632;
#pragma unroll
            for (int b = 0; b < 4; ++b) dst[b * ld + n] = a[b]; }
    }
}

__device__ __forceinline__ void phase3(const Params& p, int gtid, int gth, int cg0) {
    const bf16_t* LO = (const bf16_t*)(p.ws + WS_LO); bf16_t* LA = (bf16_t*)(p.ws + WS_LA); const float* mu = p.in[I_MU] + 1536;
    const int c0 = cg0 * 128 + (gtid & 15) * 8;
    float m[8];
#pragma unroll
    for (int j = 0; j < 8; ++j) m[j] = mu[c0 + j];
    for (int base = gtid; base < NT * 16; base += 4 * gth) {
        u32x4 cur[4], prv[4];
#pragma unroll
        for (int k = 0; k < 4; ++k) { const int it = base + k * gth; cur[k] = (u32x4){0u, 0u, 0u, 0u}; prv[k] = (u32x4){0u, 0u, 0u, 0u};
            if (it < NT * 16) { const int t = it >> 4; cur[k] = ldnt((const u32x4*)(LO + (size_t)t * 256 + c0)); if ((t & (SEQ - 1)) != 0) prv[k] = *(const u32x4*)(LO + (size_t)(t - 1) * 256 + c0); } }
#pragma unroll
        for (int k = 0; k < 4; ++k) { const int it = base + k * gth;
            if (it < NT * 16) { const int t = it >> 4; float zc[8], zp[8], o[8]; unpack8(cur[k], zc); unpack8(prv[k], zp);
#pragma unroll
                for (int j = 0; j < 8; ++j) { const float z = zc[j] + m[j] * (zp[j] - zc[j]); o[j] = (c0 < 64) ? tanhf_(z) : (c0 < 128 ? z : sigmoidf_(z)); }
                *(u32x4*)(LA + (size_t)t * 256 + c0) = pack8a(o); } }
    }
}

__device__ __forceinline__ void s5_carry(const Params& p, int item) {
    const int lane = otid() & 63, g = item >> 2, b = item & 3;
    const float dt = expf(p.in[I_SLDT][g]); const float are = p.in[I_SARE][g * 64 + lane], aim = p.in[I_SAIM][g * 64 + lane];
    const float mag = expf(16.0f * dt * are), ang = 16.0f * dt * aim, ar = mag * cosf(ang), ai = mag * sinf(ang);
    const bf16_t* SLOC = (const bf16_t*)(p.ws + WS_SLOC); bf16_t* USIN = (bf16_t*)(p.ws + WS_USIN);
    float sr = 0.f, si = 0.f;
    const size_t r0 = (size_t)g * 2048 + b * 512;
    for (int c0 = 0; c0 < 512; c0 += 32) {
        unsigned short lr[32], li[32];
#pragma unroll
        for (int j = 0; j < 32; ++j) { lr[j] = SLOC[(r0 + c0 + j) * 128 + lane]; li[j] = SLOC[(r0 + c0 + j) * 128 + 64 + lane]; }
#pragma unroll
        for (int j = 0; j < 32; ++j) {
            bf16_t* dst = USIN + (r0 + c0 + j) * 384 + 256;
            dst[lane] = f2bf(sr); dst[64 + lane] = f2bf(si);
            const float nr = ar * sr - ai * si + bf2f(lr[j]), ni = ar * si + ai * sr + bf2f(li[j]);
            sr = nr; si = ni;
        }
    }
}

__device__ __forceinline__ void rwkv_prepass(const Params& p, int cidx) {
    const int lane = otid() & 63, c0 = lane * 8;
    unsigned char* ws = p.ws;
    const bf16_t* R = (const bf16_t*)(ws + WS_R); const bf16_t* K = (const bf16_t*)(ws + WS_K); const bf16_t* V = (const bf16_t*)(ws + WS_V);
    const bf16_t* W = (const bf16_t*)(ws + WS_W); const bf16_t* AA = (const bf16_t*)(ws + WS_AA);
    bf16_t* WR = (bf16_t*)(ws + WS_WR); bf16_t* KP = (bf16_t*)(ws + WS_KP); bf16_t* AL = (bf16_t*)(ws + WS_AL); bf16_t* BE = (bf16_t*)(ws + WS_BE); bf16_t* VS = (bf16_t*)(ws + WS_VS);
    f32x4* SC = (f32x4*)(ws + WS_SC);
    (void)cidx;
    float mur[8], muk[8], muv[8], kkc[8], kac[8], rkc[8];
#pragma unroll
    for (int j = 0; j < 8; ++j) { mur[j] = p.in[I_MU][c0 + j]; muk[j] = p.in[I_MU][512 + c0 + j]; muv[j] = p.in[I_MU][1024 + c0 + j]; kkc[j] = p.in[I_KK][c0 + j]; kac[j] = p.in[I_KA][c0 + j]; rkc[j] = p.in[I_RK][c0 + j]; }
    struct Row { u32x4 r, k, v, a, w; };
#define PRE_LD(d, t) do { const size_t e_ = (size_t)(t) * 512 + c0; d.r = ldnt((const u32x4*)(R + e_)); d.k = ldnt((const u32x4*)(K + e_)); d.v = ldnt((const u32x4*)(V + e_)); d.a = ldnt((const u32x4*)(AA + e_)); \
        d.w = *(const u32x4*)(W + e_); } while (0)
    const int gw_ = blockIdx.x * 8 + (otid() >> 6), nw_ = gridDim.x * 8;
    for (int it = gw_; it < NT / 8; it += nw_) {
        const int t0 = it * 8;
        float rp[8], kp[8], vp[8];
        if ((t0 & (SEQ - 1)) != 0) { const size_t e = (size_t)(t0 - 1) * 512 + c0; unpack8(*(const u32x4*)(R + e), rp); unpack8(*(const u32x4*)(K + e), kp); unpack8(*(const u32x4*)(V + e), vp); }
        else {
#pragma unroll
            for (int j = 0; j < 8; ++j) { rp[j] = 0.f; kp[j] = 0.f; vp[j] = 0.f; } }
        Row cur, nxt; PRE_LD(cur, t0);
#pragma unroll
        for (int tt = 0; tt < 8; ++tt) {
            const int t = t0 + tt;
            if (tt + 1 < 8) PRE_LD(nxt, t + 1);
            float rc[8], kc[8], vc[8], a[8]; unpack8(cur.r, rc); unpack8(cur.k, kc); unpack8(cur.v, vc); unpack8(cur.a, a);
            float w[8]; unpack8(cur.w, w);
#pragma unroll
            for (int j = 0; j < 8; ++j) w[j] = __expf(-w[j]);
            float r[8], k[8], v[8], kk[8], k2[8], be[8], o[8]; float ss = 0.f;
#pragma unroll
            for (int j = 0; j < 8; ++j) { r[j] = rc[j] + mur[j] * (rp[j] - rc[j]); k[j] = kc[j] + muk[j] * (kp[j] - kc[j]); v[j] = vc[j] + muv[j] * (vp[j] - vc[j]); kk[j] = k[j] * kkc[j]; ss += kk[j] * kk[j]; }
            ss = red8(ss); const float inv = 1.0f / fmaxf(sqrtf(ss), 1e-12f);
            float br = 0.f, kr = 0.f, bc = 0.f;
#pragma unroll
            for (int j = 0; j < 8; ++j) { kk[j] *= inv; k2[j] = k[j] * (1.0f + (a[j] - 1.0f) * kac[j]); be[j] = kk[j] * a[j]; br += be[j] * r[j]; kr += k2[j] * r[j]; bc += r[j] * k2[j] * rkc[j]; }
            br = red8(br); kr = red8(kr); bc = red8(bc);
            const size_t e = (size_t)t * 512 + c0;
#pragma unroll
            for (int j = 0; j < 8; ++j) o[j] = w[j] * r[j];
            *(u32x4*)(WR + e) = pack8a(o); *(u32x4*)(KP + e) = pack8a(k2);
#pragma unroll
            for (int j = 0; j < 8; ++j) o[j] = -kk[j];
            *(u32x4*)(AL + e) = pack8a(o); *(u32x4*)(BE + e) = pack8a(be); *(u32x4*)(VS + e) = pack8a(v);
            if ((lane & 7) == 0) SC[(size_t)t * 8 + (lane >> 3)] = (f32x4){br, kr, bc, 0.f};
#pragma unroll
            for (int j = 0; j < 8; ++j) { rp[j] = rc[j]; kp[j] = kc[j]; vp[j] = vc[j]; }
            cur = nxt;
        }
    }
#undef PRE_LD
}

constexpr int CH = 32;
constexpr int HSEQ = SEQ / 2;
constexpr int CB_AL = 0, CB_BE = 8192, CB_KP = 16384, CB_WR = 24576, CB_W = 32768, CB_VS = 40960, CB_Y = 49152, CB_BYTES = 53248;
struct ScanRegs { u32x4 al, be, kp, wr, w; f32x2 sca, scb; u32x4 vs; };
__device__ __forceinline__ void scan_load(const Params& p, ScanRegs& r, int lt, size_t tg0, int h, int row0, bool phi) {
    unsigned char* ws = p.ws;
    const int tok = lt >> 3, part = lt & 7; const size_t e = (tg0 + tok) * 512 + h * 64 + part * 8;
    r.al = *(const u32x4*)((const bf16_t*)(ws + WS_AL) + e); r.be = *(const u32x4*)((const bf16_t*)(ws + WS_BE) + e);
    r.kp = *(const u32x4*)((const bf16_t*)(ws + WS_KP) + e); r.wr = *(const u32x4*)((const bf16_t*)(ws + WS_WR) + e);
    r.w = *(const u32x4*)((const bf16_t*)(ws + WS_W) + e);
    { const f32x4 s4 = ((const f32x4*)(ws + WS_SC))[(tg0 + tok) * 8 + h]; r.sca = (f32x2){s4[0], s4[1]}; }
    if (lt < 4 * CH) { r.vs = (u32x4){0u, 0u, 0u, 0u}; const f32x4 s4 = ((const f32x4*)(ws + WS_SC))[(tg0 + (lt >> 2)) * 8 + h]; r.scb = (f32x2){s4[0], s4[1]};
        if (!phi) r.vs = *(const u32x4*)((const bf16_t*)(ws + WS_VS) + (tg0 + (lt >> 2)) * 512 + h * 64 + row0 + (lt & 3) * 8); }
}
__device__ __forceinline__ void st_bf8_f32(LAS unsigned char* dst, u32x4 v) {
    *(LAS f32x4*)dst = (f32x4){bflo(v.x), bfhi(v.x), bflo(v.y), bfhi(v.y)}; *(LAS f32x4*)(dst + 16) = (f32x4){bflo(v.z), bfhi(v.z), bflo(v.w), bfhi(v.w)};
}
__device__ __forceinline__ void scan_store(LAS unsigned char* buf, const ScanRegs& r, int lt) {
    const int o = (lt >> 3) * 256 + (lt & 7) * 32;
    st_bf8_f32(buf + CB_AL + o, r.al); st_bf8_f32(buf + CB_BE + o, r.be); st_bf8_f32(buf + CB_KP + o, r.kp);
    { const float br = r.sca[0]; float a[8], wv[8]; unpack8(r.al, a); unpack8(r.wr, wv);
        *(LAS f32x4*)(buf + CB_WR + o) = (f32x4){wv[0] + br * a[0], wv[1] + br * a[1], wv[2] + br * a[2], wv[3] + br * a[3]};
        *(LAS f32x4*)(buf + CB_WR + o + 16) = (f32x4){wv[4] + br * a[4], wv[5] + br * a[5], wv[6] + br * a[6], wv[7] + br * a[7]}; }
    { float e8[8]; unpack8(r.w, e8);
        *(LAS f32x4*)(buf + CB_W + o) = (f32x4){__expf(-e8[0]), __expf(-e8[1]), __expf(-e8[2]), __expf(-e8[3])}; *(LAS f32x4*)(buf + CB_W + o + 16) = (f32x4){__expf(-e8[4]), __expf(-e8[5]), __expf(-e8[6]), __expf(-e8[7])}; }
    if (lt < 4 * CH) { LAS unsigned char* d = buf + CB_VS + (lt >> 2) * 256 + (lt & 3) * 64; const float kr = r.scb[1];
        float v[8]; unpack8(r.vs, v);
#pragma unroll
        for (int i = 0; i < 8; i += 2) *(LAS f32x4*)(d + i * 8) = (f32x4){v[i], v[i] * kr, v[i + 1], v[i + 1] * kr}; }
}
__device__ __forceinline__ void scan_yout(LAS unsigned char* buf, int tid, bf16_t* dst  ) {
    if (tid < 4 * CH) {
        const int tok = tid >> 2, qt = tid & 3;
        const f32x4 a = *(const LAS f32x4*)(buf + CB_Y + tok * 128 + qt * 32), b = *(const LAS f32x4*)(buf + CB_Y + tok * 128 + qt * 32 + 16);
        *(u32x4*)(dst + (size_t)tok * 512 + qt * 8) = pack8(a, b);
    }
}
__device__ __forceinline__ void rwkv_scan(const Params& p, int sb, LAS unsigned char* lds) {
    const int tid = otid(), wave = __builtin_amdgcn_readfirstlane(tid >> 6), lane = tid & 63;
    const int jj = sb >> 3, hh = (sb & 7) * 4 + jj / 6, role = jj % 6, b = hh >> 3, h = hh & 7, row0 = (role & 1) * 32, kind = role >> 1;
    const bool phi = (kind == 2);
    const size_t tg = (size_t)b * SEQ + (kind == 0 ? 0 : HSEQ);
    bf16_t* ydst = phi ? (bf16_t*)(p.ws + WS_YPHI) + ((size_t)b * HSEQ) * 512 + h * 64 + row0 : (bf16_t*)(p.ws + WS_Y) + tg * 512 + h * 64 + row0;
    constexpr int NCH = HSEQ / CH;
    const bool loader = wave >= 4; const int lt = tid - 256;
    ScanRegs rg;
    if (loader) { scan_load(p, rg, lt, tg, h, row0, phi); scan_store(lds, rg, lt); scan_load(p, rg, lt, tg + CH, h, row0, phi); }
    __syncthreads();
    const int rl = (wave & 3) * 8 + (lane >> 3), ko = lane & 7;
    float S[8];
#pragma unroll
    for (int i = 0; i < 8; ++i) S[i] = (phi && (row0 + rl == ko * 8 + i)) ? 1.f : 0.f;
    for (int c = 0; c < NCH; ++c) {
        LAS unsigned char* buf = lds + (c & 1) * CB_BYTES;
        LAS unsigned char* nb = lds + ((c + 1) & 1) * CB_BYTES;
        if (loader) {
            if (c > 0) scan_yout(nb, lt, ydst + (size_t)(c - 1) * CH * 512);
            if (c + 1 < NCH) scan_store(nb, rg, lt);
            if (c + 2 < NCH) scan_load(p, rg, lt, tg + (size_t)(c + 2) * CH, h, row0, phi);
        } else {
            __builtin_amdgcn_s_setprio(3);
            const LAS unsigned char* bq = buf + ko * 32;
            struct StepIn { f32x4 al0, al1, wq0, wq1, be0, be1, kp0, kp1, w0, w1; f32x2 rec; };
#define SCAN_LD(d, s) do { d.al0 = *(const LAS f32x4*)(bq + CB_AL + (s) * 256); d.al1 = *(const LAS f32x4*)(bq + CB_AL + (s) * 256 + 16); d.wq0 = *(const LAS f32x4*)(bq + CB_WR + (s) * 256); d.wq1 = *(const LAS f32x4*)(bq + CB_WR + (s) * 256 + 16); \
        d.be0 = *(const LAS f32x4*)(bq + CB_BE + (s) * 256); d.be1 = *(const LAS f32x4*)(bq + CB_BE + (s) * 256 + 16); d.kp0 = *(const LAS f32x4*)(bq + CB_KP + (s) * 256); d.kp1 = *(const LAS f32x4*)(bq + CB_KP + (s) * 256 + 16); \
        d.w0 = *(const LAS f32x4*)(bq + CB_W + (s) * 256); d.w1 = *(const LAS f32x4*)(bq + CB_W + (s) * 256 + 16); d.rec = *(const LAS f32x2*)(buf + CB_VS + (s) * 256 + rl * 8); } while (0)
            StepIn cur, n1;
            SCAN_LD(cur, 0);
#pragma unroll
            for (int s = 0; s < CH; ++s) {
                if (s + 1 < CH) SCAN_LD(n1, s + 1);
                const float al[8] = {cur.al0[0], cur.al0[1], cur.al0[2], cur.al0[3], cur.al1[0], cur.al1[1], cur.al1[2], cur.al1[3]};
                const float wq[8] = {cur.wq0[0], cur.wq0[1], cur.wq0[2], cur.wq0[3], cur.wq1[0], cur.wq1[1], cur.wq1[2], cur.wq1[3]};
                const float be[8] = {cur.be0[0], cur.be0[1], cur.be0[2], cur.be0[3], cur.be1[0], cur.be1[1], cur.be1[2], cur.be1[3]};
                const float kp[8] = {cur.kp0[0], cur.kp0[1], cur.kp0[2], cur.kp0[3], cur.kp1[0], cur.kp1[1], cur.kp1[2], cur.kp1[3]};
                const float w[8] = {cur.w0[0], cur.w0[1], cur.w0[2], cur.w0[3], cur.w1[0], cur.w1[1], cur.w1[2], cur.w1[3]};
                f32x2 t0 = (f32x2){S[0], S[1]} * (f32x2){al[0], al[1]}, t1 = (f32x2){S[0], S[1]} * (f32x2){wq[0], wq[1]};
#pragma unroll
                for (int i = 2; i < 8; i += 2) { t0 = (f32x2){S[i], S[i + 1]} * (f32x2){al[i], al[i + 1]} + t0; t1 = (f32x2){S[i], S[i + 1]} * (f32x2){wq[i], wq[i + 1]} + t1; }
                const float sa = red8(t0[0] + t0[1]);
                const float y = red8(t1[0] + t1[1]) + cur.rec[1];
                const f32x2 sa2 = (f32x2){sa, sa}, vv2 = (f32x2){cur.rec[0], cur.rec[0]};
#pragma unroll
                for (int i = 0; i < 8; i += 2) { const f32x2 sn = (f32x2){S[i], S[i + 1]} * (f32x2){w[i], w[i + 1]} + sa2 * (f32x2){be[i], be[i + 1]} + vv2 * (f32x2){kp[i], kp[i + 1]}; S[i] = sn[0]; S[i + 1] = sn[1]; }
                *(LAS float*)(buf + CB_Y + s * 128 + rl * 4) = y;
                cur = n1;
            }
#undef SCAN_LD
            __builtin_amdgcn_s_setprio(0);
        }
        __syncthreads();
    }
    if (loader) scan_yout(lds + ((NCH - 1) & 1) * CB_BYTES, lt, ydst + (size_t)(NCH - 1) * CH * 512);
    if (kind == 0 && wave < 4) { float* d = (float*)(p.ws + WS_SH) + ((size_t)hh * 64 + row0 + rl) * 64 + ko * 8;
        *(f32x4*)d = (f32x4){S[0], S[1], S[2], S[3]}; *(f32x4*)(d + 4) = (f32x4){S[4], S[5], S[6], S[7]}; }
    __syncthreads();
}
typedef float f32x16 __attribute__((ext_vector_type(16)));
__device__ __forceinline__ void rwkv_fixup(const Params& p) {
    const int tid = otid(), lane = tid & 63, gw = blockIdx.x * 8 + (tid >> 6), nw = gridDim.x * 8, r = lane & 31, hf = lane >> 5;
    const bf16_t* YPHI = (const bf16_t*)(p.ws + WS_YPHI); const float* SH = (const float*)(p.ws + WS_SH); bf16_t* Y = (bf16_t*)(p.ws + WS_Y);
    for (int u = gw; u < 32 * (HSEQ / 32); u += nw) {
        const int hh = u / (HSEQ / 32), tile = u % (HSEQ / 32), b = hh >> 3, h = hh & 7;
        const size_t tphi = (size_t)b * HSEQ + tile * 32, t0 = (size_t)b * SEQ + HSEQ + tile * 32;
        bf16x8 af[4];
#pragma unroll
        for (int s = 0; s < 4; ++s) af[s] = *(const bf16x8*)(YPHI + (tphi + r) * 512 + h * 64 + 16 * s + 8 * hf);
#pragma unroll
        for (int vt = 0; vt < 2; ++vt) {
            const float* srow = SH + ((size_t)hh * 64 + vt * 32 + r) * 64;
            f32x16 acc;
#pragma unroll
            for (int i = 0; i < 16; ++i) acc[i] = 0.f;
#pragma unroll
            for (int s = 0; s < 4; ++s) {
                const f32x4 x0 = *(const f32x4*)(srow + 16 * s + 8 * hf), x1 = *(const f32x4*)(srow + 16 * s + 8 * hf + 4);
                const u32x4 w = pack8(x0, x1); bf16x8 bfr = __builtin_bit_cast(bf16x8, w);
                acc = __builtin_amdgcn_mfma_f32_32x32x16_bf16(af[s], bfr, acc, 0, 0, 0);
            }
#pragma unroll
            for (int i = 0; i < 16; ++i) {
                const int row = (i & 3) + 8 * (i >> 2) + 4 * hf;
                bf16_t* yp = Y + (t0 + row) * 512 + h * 64 + vt * 32 + r;
                *yp = f2bf(bf2f(*yp) + acc[i]);
            }
        }
    }
}

__device__ __forceinline__ void phase8(const Params& p) {
    const int tid = otid(), lane = tid & 63, c0 = lane * 8, gw = blockIdx.x * 8 + (tid >> 6), nw = gridDim.x * 8;
    unsigned char* ws = p.ws;
    const bf16_t* Y = (const bf16_t*)(ws + WS_Y); const bf16_t* VS = (const bf16_t*)(ws + WS_VS); const bf16_t* G = (const bf16_t*)(ws + WS_G); const bf16_t* GLUO = (const bf16_t*)(ws + WS_GLUO);
    const f32x4* SC = (const f32x4*)(ws + WS_SC);
    bf16_t* MIX = (bf16_t*)(ws + WS_MIX);
    float lnw[8], lnb[8];
#pragma unroll
    for (int j = 0; j < 8; ++j) { lnw[j] = p.in[I_LNW][c0 + j]; lnb[j] = p.in[I_LNB][c0 + j]; }
    struct Row { u32x4 y, v, g; f32x4 sc; };
#define P8_LD(d, t) do { const size_t e_ = (size_t)(t) * 512 + c0; d.y = ldnt((const u32x4*)(Y + e_)); d.v = ldnt((const u32x4*)(VS + e_)); d.g = ldnt((const u32x4*)(G + e_)); \
        d.sc = SC[(size_t)(t) * 8 + (lane >> 3)]; } while (0)
    const int per = (NT + nw - 1) / nw, tbeg = gw * per, tend = (tbeg + per < NT) ? tbeg + per : NT;
    if (tbeg >= NT) return;
    Row cur, nxt; P8_LD(cur, tbeg);
    for (int t = tbeg; t < tend; ++t) {
        if (t + 1 < tend) P8_LD(nxt, t + 1);
        float y[8], v[8], g[8], o[8]; unpack8(cur.y, y); unpack8(cur.v, v); unpack8(cur.g, g);
        float sm = 0.f;
#pragma unroll
        for (int j = 0; j < 8; ++j) sm += y[j];
        const float mean = red8(sm) * (1.0f / 64.0f); float sq = 0.f;
#pragma unroll
        for (int j = 0; j < 8; ++j) { y[j] -= mean; sq += y[j] * y[j]; }
        const float rstd = rsqrtf(red8(sq) * (1.0f / 64.0f) + 64e-5f), bc = cur.sc[2];
#pragma unroll
        for (int j = 0; j < 8; ++j) o[j] = (y[j] * rstd * lnw[j] + lnb[j] + bc * v[j]) * g[j];
        *(u32x4*)(MIX + (size_t)t * 1024 + c0) = pack8a(o);
        cur = nxt;
    }
#undef P8_LD
}

__device__ __forceinline__ void s5_mix_half(const Params& p, int b2, int G2) {
    const int tid = otid(), lane = tid & 63, c0 = lane * 8, gw = b2 * 8 + (tid >> 6), nw = G2 * 8;
    const bf16_t* GLUO = (const bf16_t*)(p.ws + WS_GLUO); const float* rss5 = (const float*)(p.ws + WS_SMALL + SM_RSP5); bf16_t* MIX = (bf16_t*)(p.ws + WS_MIX);
    float gain[8];
#pragma unroll
    for (int j = 0; j < 8; ++j) gain[j] = p.in[I_SGAIN][c0 + j];
    for (int t0 = gw * 4; t0 < NT; t0 += nw * 4) {
        u32x4 gv[4]; float rs[4];
#pragma unroll
        for (int k = 0; k < 4; ++k) { gv[k] = *(const u32x4*)(GLUO + (size_t)(t0 + k) * 512 + c0); const f32x4* rp = (const f32x4*)(rss5 + (size_t)(t0 + k) * 8); const f32x4 q4 = rp[0] + rp[1]; rs[k] = rsqrtf(((q4[0] + q4[1]) + (q4[2] + q4[3])) * (1.0f / 512.0f) + 1e-6f); }
#pragma unroll
        for (int k = 0; k < 4; ++k) { float o[8]; unpack8(gv[k], o);
#pragma unroll
            for (int j = 0; j < 8; ++j) o[j] = o[j] * rs[k] * gain[j];
            *(u32x4*)(MIX + (size_t)(t0 + k) * 1024 + 512 + c0) = pack8a(o); }
    }
}

__device__ __forceinline__ void phase12(const Params& p) {
    const int tid = otid(), lane = tid & 63, gw = blockIdx.x * 8 + (tid >> 6), nw = gridDim.x * 8;
    const float* rss3 = (const float*)(p.ws + WS_RSP3); const bf16_t* X2 = (const bf16_t*)(p.ws + WS_X2B);
    f32x4 g[4];
#pragma unroll
    for (int i = 0; i < 4; ++i) g[i] = *(const f32x4*)(p.in[I_FGAIN] + i * 256 + lane * 4);
    for (int row0 = gw * 2; row0 < NT; row0 += nw * 2) {
        u32x2 xb[2][4]; float rs[2];
#pragma unroll
        for (int r = 0; r < 2; ++r) { const f32x4* rp = (const f32x4*)(rss3 + (size_t)(row0 + r) * 16); const f32x4 q4 = (rp[0] + rp[1]) + (rp[2] + rp[3]); rs[r] = rsqrtf(((q4[0] + q4[1]) + (q4[2] + q4[3])) * (1.0f / 1024.0f) + 1e-6f);
#pragma unroll
            for (int i = 0; i < 4; ++i) xb[r][i] = ldnt((const u32x2*)(X2 + (size_t)(row0 + r) * 1024 + i * 256 + lane * 4)); }
#pragma unroll
        for (int r = 0; r < 2; ++r)
#pragma unroll
            for (int i = 0; i < 4; ++i) { const f32x4 v = (f32x4){bflo(xb[r][i].x), bfhi(xb[r][i].x), bflo(xb[r][i].y), bfhi(xb[r][i].y)};
                stnt((f32x4*)(p.out + (size_t)(row0 + r) * 1024 + i * 256 + lane * 4), v * rs[r] * g[i]); }
    }
}

__device__ __forceinline__ void fast_barrier(unsigned* ctr, unsigned target, unsigned ep) {
    asm volatile("s_waitcnt vmcnt(0) lgkmcnt(0)" ::: "memory");
    __syncthreads();
    if (otid() == 0) {
        __builtin_amdgcn_fence(__ATOMIC_RELEASE, "agent");
        asm volatile("s_waitcnt vmcnt(0)" ::: "memory");
        const unsigned old = __hip_atomic_fetch_add(ctr, 1u, __ATOMIC_RELAXED, __HIP_MEMORY_SCOPE_AGENT);
        if (old + 1u == target) __hip_atomic_store(ctr + 64, ep, __ATOMIC_RELAXED, __HIP_MEMORY_SCOPE_AGENT);
        else while (__hip_atomic_load(ctr + 64, __ATOMIC_RELAXED, __HIP_MEMORY_SCOPE_AGENT) < ep) __builtin_amdgcn_s_sleep(1);
        __builtin_amdgcn_fence(__ATOMIC_ACQUIRE, "agent");
        asm volatile("s_waitcnt vmcnt(0)" ::: "memory");
    }
    __syncthreads();
}
__device__ __attribute__((noinline)) void gsync() { cg::this_grid().sync(); }
__global__ void __launch_bounds__(512) fwd_megakernel(Params p_arg) {
    const Params& p = *(const Params*)__builtin_amdgcn_kernarg_segment_ptr();
    extern __shared__ __attribute__((aligned(16))) unsigned char lds_raw[];
    LAS unsigned char* lds = (LAS unsigned char*)lds_raw;
    unsigned char* ws = p.ws;
    const int G = gridDim.x, blk = blockIdx.x;
    float* ada = (float*)(ws + WS_SMALL + SM_ADA);
    unsigned gep = 0; unsigned* gctr = (unsigned*)(ws + WS_SMALL + SM_CTR) + 256;
#define GBAR() do { ++gep; fast_barrier(gctr, gep * (unsigned)G, gep); } while (0)

    if (gridDim.x == 0x7fffffffu) gsync();
    REP(0) { phase0(p, lds, rep_ == 0); GBAR(); }
    REP(1) { phase1(p); GBAR(); }
    REP(2) {
        pg8::Gemm g{(const bf16_t*)(ws + WS_A1), (const bf16_t*)(ws + WS_WIN_T), NT, DIN, 1024, 1024, 1024, 30, 0};
        pg8::StaticOrder S; S.init(NT, DIN, G, blk);
        EpiIn E{(bf16_t*)(ws + WS_R), (const float*)(ws + WS_SMALL + SM_RSTD1), (const float*)(ws + WS_SMALL + SM_BIAS1)};
        pg8::gemm_phase(lds, g, S, E);
        {   const int nun = (NT / 256) * (DIN / 256), rem = nun % G;
            if (rep_ == 0) { if (rem == 0) deferred_setup(p, lds, blk, G); else if (blk >= rem) deferred_setup(p, lds, blk - rem, G - rem); } }
        GBAR();
    }
    REP(3) { phase3(p, blk * 512 + otid(), G * 512, 0); GBAR(); }
    REP(4) {
        pg8::Gemm g{(const bf16_t*)(ws + WS_LA), (const bf16_t*)(ws + WS_LORA_T), NT, 1024, 128, 256, 256, 30, 0};
        pg8::StaticOrder S; S.init(NT, 1024, G, blk);
        EpiLora E{(bf16_t*)(ws + WS_W), (bf16_t*)(ws + WS_AA), (bf16_t*)(ws + WS_G), p.in[I_W0], p.in[I_A0], 0};
        pg8::gemm_phase(lds, g, S, E);
        GBAR();
    }
    REP(5) { rwkv_prepass(p, rep_); GBAR(); }
    REP(7) {
        const int nsc = (G >= 256) ? 192 : (G * 3) / 4;
        if (blk < nsc) { for (int sb = blk; sb < 192; sb += nsc) rwkv_scan(p, sb, lds); }
        else if (rep_ == 0) {
            const int G2 = G - nsc, b2 = blk - nsc; unsigned* sctr = (unsigned*)(ws + WS_SMALL + SM_CTR) + 512;
            phase3(p, b2 * 512 + otid(), G2 * 512, 1);
            fast_barrier(sctr, (unsigned)G2, 1u);
            {   pg8::Gemm g2{(const bf16_t*)(ws + WS_USIN), (const bf16_t*)(ws + WS_S5W), 65536, 256, 256, 384, 256, 3, (size_t)256 * 256 * 2};
                pg8::StaticOrder S2; S2.init(65536, 256, G2, b2);
                EpiS1 E2{(bf16_t*)(ws + WS_SLOC)};
                pg8::gemm_phase(lds, g2, S2, E2); }
            fast_barrier(sctr, 2u * (unsigned)G2, 2u);
            for (int it = b2 + (otid() >> 6) * G2; it < 128; it += 8 * G2) s5_carry(p, it);
            fast_barrier(sctr, 3u * (unsigned)G2, 3u);
            {   pg8::Gemm g{(const bf16_t*)(ws + WS_USIN), (const bf16_t*)(ws + WS_S5TV), 65536, 256, 384, 384, 384, 3, (size_t)256 * 384 * 2};
                pg8::StaticOrder S; S.init(65536, 256, G2, b2);
                EpiS2 E{(const bf16_t*)(ws + WS_USIN), (bf16_t*)(ws + WS_ZZ), p.in[I_SD]};
                pg8::gemm_phase(lds, g, S, E); }
            fast_barrier(sctr, 4u * (unsigned)G2, 4u);
            {   pg8::Gemm g{(const bf16_t*)(ws + WS_ZZ), (const bf16_t*)(ws + WS_WGLU_T), NT, 512, 512, 512, 512, 30, 0};
                pg8::StaticOrder S; S.init(NT, 512, G2, b2);
                EpiGlu E{(const bf16_t*)(ws + WS_ZZ), (bf16_t*)(ws + WS_GLUO), p.in[I_BGLU], (float*)(ws + WS_SMALL + SM_RSP5)};
                pg8::gemm_phase(lds, g, S, E); }
            fast_barrier(sctr, 5u * (unsigned)G2, 5u);
            s5_mix_half(p, b2, G2);
            {   pg8::Gemm g{(const bf16_t*)(ws + WS_LA), (const bf16_t*)(ws + WS_LORA_T) + (size_t)1024 * 256, NT, 512, 256, 256, 256, 30, 0};
                pg8::StaticOrder S; S.init(NT, 512, G2, b2);
                EpiLora E{(bf16_t*)(ws + WS_W), (bf16_t*)(ws + WS_AA), (bf16_t*)(ws + WS_G), p.in[I_W0], p.in[I_A0], 4};
                pg8::gemm_phase(lds, g, S, E); }
            late_weights(p, b2 * 512 + otid(), G2 * 512);
            fast_barrier(sctr, 6u * (unsigned)G2, 6u);
            late_bias2(p, b2 * 8 + (otid() >> 6), G2 * 8);
        }
        GBAR();
    }
    REP(13) { rwkv_fixup(p); GBAR(); }
    REP(8) { phase8(p); GBAR(); }
    REP(9) {
        pg8::Gemm g{(const bf16_t*)(ws + WS_MIX), (const bf16_t*)(ws + WS_WOUT_T), NT, 1024, 1024, 1024, 1024, 30, 0};
        pg8::StaticOrder S; S.init(NT, 1024, G, blk);
        EpiOut E{p.in[I_X], (bf16_t*)(ws + WS_X1), (bf16_t*)(ws + WS_A2), ada, (float*)(ws + WS_SMALL + SM_RSP2)};
        pg8::gemm_phase(lds, g, S, E);
        GBAR();
    }
    REP(10) {
        pg8::Gemm g{(const bf16_t*)(ws + WS_A2), (const bf16_t*)(ws + WS_GU_T), NT, 5632, 1024, 1024, 1024, 30, 0};
        pg8::StaticOrder S; S.init(NT, 5632, G, blk);
        EpiGU E{(bf16_t*)(ws + WS_HMID), (const float*)(ws + WS_SMALL + SM_RSP2), (const float*)(ws + WS_SMALL + SM_BIAS2)};
        pg8::gemm_phase(lds, g, S, E);
        GBAR();
    }
    REP(11) {
        pg8::Gemm g{(const bf16_t*)(ws + WS_HMID), (const bf16_t*)(ws + WS_DOWN_T), NT, 1024, DFF, DFF, DFF, 30, 0};
        pg8::StaticOrder S; S.init(NT, 1024, G, blk);
        EpiDown E{(const bf16_t*)(ws + WS_X1), (bf16_t*)(ws + WS_X2B), ada, (float*)(ws + WS_RSP3)};
        pg8::gemm_phase(lds, g, S, E);
        GBAR();
    }
    phase12(p);
}

extern "C" void kernel_launch(void* const* d_in, const int* in_sizes, int n_in, void* d_out, int out_size, void* d_ws, size_t ws_size, hipStream_t stream) {
    constexpr int LDS_BYTES = pg8::STAGE_BYTES;
    static int grid_blocks = 0;
    if (!grid_blocks) {
        int dev = 0, cus = 0, per_cu = 0;
        hipGetDevice(&dev);
        hipDeviceGetAttribute(&cus, hipDeviceAttributeMultiprocessorCount, dev);
        hipFuncSetAttribute((const void*)fwd_megakernel, hipFuncAttributeMaxDynamicSharedMemorySize, LDS_BYTES);
        hipOccupancyMaxActiveBlocksPerMultiprocessor(&per_cu, (const void*)fwd_megakernel, 512, LDS_BYTES);
        if (per_cu < 1) per_cu = 1;
        if (per_cu > 1) per_cu = 1;
        grid_blocks = cus * per_cu;
        if (ws_size < WS_END) fprintf(stderr, "kernel_launch: workspace too small: %zu < %zu\n", ws_size, (size_t)WS_END);
        (void)hipGetLastError();
    }
    hipMemsetAsync((unsigned char*)d_ws + WS_SMALL, 0, ZERO_BYTES, stream);
    Params p{};
    for (int i = 0; i < 32; ++i) p.in[i] = (const float*)d_in[i];
    p.out = (float*)d_out; p.ws = (unsigned char*)d_ws;
    void* args[] = {&p};
    hipError_t e = hipLaunchCooperativeKernel((const void*)fwd_megakernel, dim3(grid_blocks), dim3(512), args, LDS_BYTES, stream);
    if (e != hipSuccess) fprintf(stderr, "cooperative launch failed: %s (grid %d)\n", hipGetErrorString(e), grid_blocks);
}
```
